# Optimizing an MI355X kernel written in HIP

```python
import math
import jax, jax.numpy as jnp
from jax import lax
import numpy as np

D_MODEL = 1024
BATCH = 16
SEQ = 2048
DEPTH = 1

HGRN_HEADS = 8
HGRN_DK = 64
HGRN_DV = 64
HGRN_KEY = HGRN_HEADS * HGRN_DK
HGRN_WIDTH = HGRN_HEADS * HGRN_DV
SB_HEADS = 8
SB_DH = 64
SB_WIDTH = SB_HEADS * SB_DH
D_MIX = HGRN_WIDTH + SB_WIDTH
IN_COLS = 2 * HGRN_KEY + 2 * HGRN_WIDTH + 3 * SB_WIDTH
CHUNK = 64
Q_BLOCK = 128
D_FF = -(-8 * D_MODEL // (3 * 256)) * 256
EPS = 1e-6

kernel_name = "hymba_hgrn2_stickbreaking_block"


def rmsnorm(x, g):
    xf = x.astype(jnp.float32)
    y = xf * lax.rsqrt(jnp.mean(xf * xf, axis=-1, keepdims=True) + EPS)
    return (y * g.astype(jnp.float32)).astype(x.dtype)


def hgrn2_mix(q, f_logit, inp, gate, lb, norm_g):
    B, S, _ = q.shape
    n_chunks = S // CHUNK
    dt = q.dtype

    def heads(t, d):
        t = t.astype(jnp.float32).reshape(B, n_chunks, CHUNK, HGRN_HEADS, d)
        return jnp.transpose(t, (0, 3, 1, 2, 4))

    lbf = lb.astype(jnp.float32)
    f = lbf + (1.0 - lbf) * jax.nn.sigmoid(f_logit.astype(jnp.float32))
    qh = heads(q, HGRN_DK)
    fh = heads(f, HGRN_DK)
    kh = 1.0 - fh
    vh = heads(inp, HGRN_DV)
    b = jnp.cumsum(jnp.log(fh), axis=3)
    b_end = b[:, :, :, -1:, :]

    qe = qh * jnp.exp(b)
    ke = kh * jnp.exp(-b)
    scores = jnp.einsum('bhnid,bhnjd->bhnij', qe, ke)
    tri = jnp.tril(jnp.ones((CHUNK, CHUNK), dtype=bool))
    scores = jnp.where(tri, scores, 0.0)
    o_intra = jnp.einsum('bhnij,bhnje->bhnie', scores, vh)

    kv = jnp.einsum('bhncd,bhnce->bhnde', kh * jnp.exp(b_end - b), vh)
    decay = jnp.exp(b_end[:, :, :, 0, :])

    def step(state, xs):
        dec, upd = xs
        return dec[..., None] * state + upd, state

    s0 = jnp.zeros((B, HGRN_HEADS, HGRN_DK, HGRN_DV), jnp.float32)
    _, s_prev = lax.scan(step, s0, (jnp.moveaxis(decay, 2, 0), jnp.moveaxis(kv, 2, 0)))
    s_prev = jnp.moveaxis(s_prev, 0, 2)
    o_inter = jnp.einsum('bhncd,bhnde->bhnce', qe, s_prev)

    o = o_intra + o_inter
    o = jnp.transpose(o, (0, 2, 3, 1, 4)).reshape(B, S, HGRN_HEADS, HGRN_DV)
    o = o * lax.rsqrt(jnp.mean(o * o, axis=-1, keepdims=True) + EPS)
    o = o.reshape(B, S, HGRN_WIDTH) * norm_g.astype(jnp.float32)
    o = o * jax.nn.silu(gate.astype(jnp.float32))
    return o.astype(dt)


def stick_breaking_mix(q, k, v, norm_g):
    B, S, _ = q.shape
    dt = q.dtype

    def heads(t):
        return jnp.transpose(t.astype(jnp.float32).reshape(B, S, SB_HEADS, SB_DH), (0, 2, 1, 3))

    qh, kh, vh = heads(q), heads(k), heads(v)
    scale = 1.0 / math.sqrt(SB_DH)
    outs = []
    for blk in range(S // Q_BLOCK):
        start = blk * Q_BLOCK
        end = start + Q_BLOCK
        qb = qh[:, :, start:end]
        kb = kh[:, :, :end]
        vb = vh[:, :, :end]
        z = jnp.einsum('bhqd,bhkd->bhqk', qb, kb) * scale
        q_pos = start + jnp.arange(Q_BLOCK)
        k_pos = jnp.arange(end)
        mask = k_pos[None, :] < q_pos[:, None]
        c = jnp.where(mask, jax.nn.softplus(z), 0.0)
        after = lax.cumsum(c, axis=3, reverse=True) - c
        attn = jnp.where(mask, jnp.exp(jax.nn.log_sigmoid(z) - after), 0.0)
        outs.append(jnp.einsum('bhqk,bhkd->bhqd', attn, vb))
    o = jnp.concatenate(outs, axis=2)
    o = jnp.transpose(o, (0, 2, 1, 3))
    o = o * lax.rsqrt(jnp.mean(o * o, axis=-1, keepdims=True) + EPS)
    o = o.reshape(B, S, SB_WIDTH) * norm_g.astype(jnp.float32)
    return o.astype(dt)


def setup_inputs(seed: int = 0) -> dict:
    key = jax.random.key(seed)
    ks = jax.random.split(key, 12)
    f32 = jnp.float32

    def w(k, shape, fan_in):
        return jax.random.normal(k, shape, f32) * fan_in ** -0.5

    def gain(k, shape):
        return 1.0 + 0.01 * jax.random.normal(k, shape, f32)

    return {
        "x": jax.random.normal(ks[0], (BATCH, SEQ, D_MODEL), f32),
        "mix_norm_g": gain(ks[1], (DEPTH, D_MODEL)),
        "w_in": w(ks[2], (DEPTH, D_MODEL, IN_COLS), D_MODEL),
        "lower_bounds": 0.1 * jax.random.normal(ks[3], (DEPTH + 1, HGRN_KEY), f32),
        "hgrn_norm_g": gain(ks[4], (DEPTH, HGRN_WIDTH)),
        "sb_norm_g": gain(ks[5], (DEPTH, SB_WIDTH)),
        "w_out": w(ks[6], (DEPTH, D_MIX, D_MODEL), D_MIX),
        "ffn_norm_g": gain(ks[7], (DEPTH, D_MODEL)),
        "w_gate": w(ks[8], (DEPTH, D_MODEL, D_FF), D_MODEL),
        "w_up": w(ks[9], (DEPTH, D_MODEL, D_FF), D_MODEL),
        "w_down": w(ks[10], (DEPTH, D_FF, D_MODEL), D_FF),
        "final_norm_g": gain(ks[11], (D_MODEL,)),
    }


def reference(x, mix_norm_g, w_in, lower_bounds, hgrn_norm_g, sb_norm_g, w_out,
              ffn_norm_g, w_gate, w_up, w_down, final_norm_g):
    lb_all = jnp.cumsum(jax.nn.softmax(lower_bounds.astype(jnp.float32), axis=0), axis=0)
    splits = np.cumsum([HGRN_KEY, HGRN_KEY, HGRN_WIDTH, HGRN_WIDTH,
                        SB_WIDTH, SB_WIDTH])
    for l in range(DEPTH):
        h = rmsnorm(x, mix_norm_g[l])
        proj = jnp.einsum('bsd,de->bse', h, w_in[l])
        hq, hf, hi, hg, sq, sk, sv = jnp.split(proj, splits, axis=-1)
        o_a = hgrn2_mix(hq, hf, hi, hg, lb_all[l].astype(x.dtype), hgrn_norm_g[l])
        o_b = stick_breaking_mix(sq, sk, sv, sb_norm_g[l])
        mixed = jnp.concatenate([o_a, o_b], axis=-1)
        x = x + jnp.einsum('bse,ed->bsd', mixed, w_out[l])
        h = rmsnorm(x, ffn_norm_g[l])
        ff = jax.nn.silu(jnp.einsum('bsd,df->bsf', h, w_gate[l])) * jnp.einsum('bsd,df->bsf', h, w_up[l])
        x = x + jnp.einsum('bsf,fd->bsd', ff, w_down[l])
    return rmsnorm(x, final_norm_g)
```

```cpp
#include <hip/hip_runtime.h>
#include <cstdio>
#include <cstdint>

constexpr int DM = 1024, NB = 16, SEQ = 2048, MTOK = NB * SEQ, INC = 3584, DFF = 2816;
constexpr float EPS = 1e-6f;

__device__ __forceinline__ float wave_sum(float v) {
#pragma unroll
    for (int o = 1; o < 64; o <<= 1) v += __shfl_xor(v, o);
    return v;
}
__device__ __forceinline__ float sigmoidf_(float x) { return 1.0f / (1.0f + expf(-x)); }
__device__ __forceinline__ float siluf_(float x) { return x * sigmoidf_(x); }
__device__ __forceinline__ float softplusf_(float x) { return fmaxf(x, 0.f) + log1pf(expf(-fabsf(x))); }

__global__ void __launch_bounds__(256) rmsnorm_k(const float* __restrict__ x, const float* __restrict__ g, float* __restrict__ y) {
    const int row = blockIdx.x * 4 + (threadIdx.x >> 6), lane = threadIdx.x & 63;
    const float4* xr = (const float4*)(x + (size_t)row * DM) + lane;
    float4 v[4]; float s = 0.f;
#pragma unroll
    for (int j = 0; j < 4; ++j) { v[j] = xr[64 * j]; s += v[j].x * v[j].x + v[j].y * v[j].y + v[j].z * v[j].z + v[j].w * v[j].w; }
    s = wave_sum(s);
    const float r = rsqrtf(s * (1.0f / DM) + EPS);
    float4* yr = (float4*)(y + (size_t)row * DM) + lane;
#pragma unroll
    for (int j = 0; j < 4; ++j) { const float4 gv = ((const float4*)g)[lane + 64 * j]; float4 o; o.x = v[j].x * r * gv.x; o.y = v[j].y * r * gv.y; o.z = v[j].z * r * gv.z; o.w = v[j].w * r * gv.w; yr[64 * j] = o; }
}

template <int MODE>
__global__ void __launch_bounds__(256) gemm_f32_k(const float* __restrict__ A, const float* __restrict__ Bm, float* C, const float* R, int M, int N, int K) {
    __shared__ float As[16][128 + 4];
    __shared__ float Bs[16][128 + 4];
    const int t = threadIdx.x, tx = t & 15, ty = t >> 4;
    const int m0 = blockIdx.y * 128, n0 = blockIdx.x * 128;
    float acc[8][8];
#pragma unroll
    for (int i = 0; i < 8; ++i)
#pragma unroll
        for (int j = 0; j < 8; ++j) acc[i][j] = 0.f;
    for (int k0 = 0; k0 < K; k0 += 16) {
#pragma unroll
        for (int p = 0; p < 2; ++p) {
            const int r = (t >> 2) + 64 * p, c = (t & 3) * 4;
            const float4 a = *(const float4*)(A + (size_t)(m0 + r) * K + k0 + c);
            As[c + 0][r] = a.x; As[c + 1][r] = a.y; As[c + 2][r] = a.z; As[c + 3][r] = a.w;
            const int kk = (t >> 5) + 8 * p, n = (t & 31) * 4;
            const float4 b = *(const float4*)(Bm + (size_t)(k0 + kk) * N + n0 + n);
            *(float4*)&Bs[kk][n] = b;
        }
        __syncthreads();
#pragma unroll
        for (int kk = 0; kk < 16; ++kk) {
            float a[8], b[8];
            *(float4*)&a[0] = *(const float4*)&As[kk][ty * 8]; *(float4*)&a[4] = *(const float4*)&As[kk][ty * 8 + 4];
            *(float4*)&b[0] = *(const float4*)&Bs[kk][tx * 8]; *(float4*)&b[4] = *(const float4*)&Bs[kk][tx * 8 + 4];
#pragma unroll
            for (int i = 0; i < 8; ++i)
#pragma unroll
                for (int j = 0; j < 8; ++j) acc[i][j] = fmaf(a[i], b[j], acc[i][j]);
        }
        __syncthreads();
    }
#pragma unroll
    for (int i = 0; i < 8; ++i) {
        const size_t off = (size_t)(m0 + ty * 8 + i) * N + n0 + tx * 8;
#pragma unroll
        for (int j = 0; j < 8; ++j) {
            float v = acc[i][j];
            if (MODE == 1) v += R[off + j];
            if (MODE == 2) v = siluf_(C[off + j]) * v;
            C[off + j] = v;
        }
    }
}

__global__ void __launch_bounds__(256) hgrn_k(const float* __restrict__ proj, const float* __restrict__ lower_bounds, const float* __restrict__ norm_g, float* __restrict__ mixed) {
    constexpr int TS = 8;
    __shared__ float stq[TS][64], stf[TS][64], stv[TS][64], stg[TS][64];
    __shared__ float part[TS][4][64];
    const int b = blockIdx.x >> 3, h = blockIdx.x & 7, t = threadIdx.x, e = t & 63, dg = t >> 6;
    float lb[16], st[16];
#pragma unroll
    for (int i = 0; i < 16; ++i) { const int d = h * 64 + dg * 16 + i; const float l0 = lower_bounds[d], l1 = lower_bounds[512 + d]; lb[i] = 1.0f / (1.0f + expf(l1 - l0)); st[i] = 0.f; }
    const float ng = norm_g[h * 64 + e];
    for (int t0 = 0; t0 < SEQ; t0 += TS) {
        __syncthreads();
#pragma unroll
        for (int s = 0; s < TS; ++s) {
            const float* row = proj + (size_t)(b * SEQ + t0 + s) * INC + h * 64 + e;
            const float val = row[dg * 512];
            if (dg == 0) stq[s][e] = val; else if (dg == 1) stf[s][e] = val; else if (dg == 2) stv[s][e] = val; else stg[s][e] = val;
        }
        __syncthreads();
#pragma unroll
        for (int s = 0; s < TS; ++s) {
            const float ve = stv[s][e]; float po = 0.f;
#pragma unroll
            for (int i = 0; i < 16; ++i) {
                const float fl = stf[s][dg * 16 + i], q = stq[s][dg * 16 + i];
                const float f = lb[i] + (1.0f - lb[i]) * sigmoidf_(fl);
                st[i] = f * st[i] + (1.0f - f) * ve;
                po = fmaf(st[i], q, po);
            }
            part[s][dg][e] = po;
        }
        __syncthreads();
#pragma unroll
        for (int ss = 0; ss < TS / 4; ++ss) {
            const int s = dg * (TS / 4) + ss;
            const float o = (part[s][0][e] + part[s][1][e]) + (part[s][2][e] + part[s][3][e]);
            const float ms = wave_sum(o * o) * (1.0f / 64.0f);
            const float y = o * rsqrtf(ms + EPS) * ng * siluf_(stg[s][e]);
            mixed[(size_t)(b * SEQ + t0 + s) * DM + h * 64 + e] = y;
        }
    }
}

__global__ void __launch_bounds__(64) sb_k(const float* __restrict__ proj, const float* __restrict__ norm_g, float* __restrict__ mixed) {
    __shared__ float Ks[64][64];
    __shared__ float Vs[64][64];
    const int bh = blockIdx.x >> 5, qb = 31 - (blockIdx.x & 31), b = bh >> 3, h = bh & 7, lane = threadIdx.x;
    const int tq = qb * 64 + lane;
    const float* base = proj + (size_t)(b * SEQ) * INC + h * 64;
    float q[64], o[64];
    {
        const float* qp = base + (size_t)tq * INC + 2048;
#pragma unroll
        for (int d = 0; d < 64; d += 4) { const float4 v = *(const float4*)(qp + d); q[d] = v.x * 0.125f; q[d + 1] = v.y * 0.125f; q[d + 2] = v.z * 0.125f; q[d + 3] = v.w * 0.125f; }
#pragma unroll
        for (int d = 0; d < 64; ++d) o[d] = 0.f;
    }
    float Asum = 0.f;
    for (int kt = qb; kt >= 0; --kt) {
        __syncthreads();
        for (int i = 0; i < 64; ++i) {
            Ks[i][lane] = base[(size_t)(kt * 64 + i) * INC + 2560 + lane];
            Vs[i][lane] = base[(size_t)(kt * 64 + i) * INC + 3072 + lane];
        }
        __syncthreads();
        for (int j = 63; j >= 0; --j) {
            const int s = kt * 64 + j;
            float z = 0.f;
#pragma unroll
            for (int d = 0; d < 64; ++d) z = fmaf(q[d], Ks[j][d], z);
            const bool act = s < tq;
            const float c = act ? softplusf_(z) : 0.f;
            const float w = act ? expf(z - c - Asum) : 0.f;
            Asum += c;
#pragma unroll
            for (int d = 0; d < 64; ++d) o[d] = fmaf(w, Vs[j][d], o[d]);
        }
    }
    float ss = 0.f;
#pragma unroll
    for (int d = 0; d < 64; ++d) ss = fmaf(o[d], o[d], ss);
    const float r = rsqrtf(ss * (1.0f / 64.0f) + EPS);
    float* op = mixed + (size_t)(b * SEQ + tq) * DM + 512 + h * 64;
#pragma unroll
    for (int d = 0; d < 64; d += 4) {
        const float4 g = *(const float4*)(norm_g + h * 64 + d);
        float4 v; v.x = o[d] * r * g.x; v.y = o[d + 1] * r * g.y; v.z = o[d + 2] * r * g.z; v.w = o[d + 3] * r * g.w;
        *(float4*)(op + d) = v;
    }
}

extern "C" void kernel_launch(void* const* d_in, const int* in_sizes, int n_in, void* d_out, int out_size, void* d_ws, size_t ws_size, hipStream_t stream) {
    const float* x = (const float*)d_in[0];
    const float* mix_g = (const float*)d_in[1];
    const float* w_in = (const float*)d_in[2];
    const float* lbnd = (const float*)d_in[3];
    const float* hg = (const float*)d_in[4];
    const float* sg = (const float*)d_in[5];
    const float* w_out = (const float*)d_in[6];
    const float* ffn_g = (const float*)d_in[7];
    const float* w_gate = (const float*)d_in[8];
    const float* w_up = (const float*)d_in[9];
    const float* w_down = (const float*)d_in[10];
    const float* fin_g = (const float*)d_in[11];
    float* out = (float*)d_out;
    char* ws = (char*)d_ws;
    constexpr size_t MiB = 1u << 20;
    if (ws_size < 512 * MiB) { fprintf(stderr, "ws too small: %zu\n", ws_size); return; }
    float* proj = (float*)ws;
    float* hbuf = out;
    float* x1 = (float*)ws;
    float* ff = (float*)(ws + 128 * MiB);

    rmsnorm_k<<<MTOK / 4, 256, 0, stream>>>(x, mix_g, hbuf);
    gemm_f32_k<0><<<dim3(INC / 128, MTOK / 128), 256, 0, stream>>>(hbuf, w_in, proj, nullptr, MTOK, INC, DM);
    float* mixed = out;
    hgrn_k<<<NB * 8, 256, 0, stream>>>(proj, lbnd, hg, mixed);
    sb_k<<<NB * 8 * 32, 64, 0, stream>>>(proj, sg, mixed);
    gemm_f32_k<1><<<dim3(DM / 128, MTOK / 128), 256, 0, stream>>>(mixed, w_out, x1, x, MTOK, DM, DM);
    float* h2 = out;
    rmsnorm_k<<<MTOK / 4, 256, 0, stream>>>(x1, ffn_g, h2);
    gemm_f32_k<0><<<dim3(DFF / 128, MTOK / 128), 256, 0, stream>>>(h2, w_gate, ff, nullptr, MTOK, DFF, DM);
    gemm_f32_k<2><<<dim3(DFF / 128, MTOK / 128), 256, 0, stream>>>(h2, w_up, ff, nullptr, MTOK, DFF, DM);
    gemm_f32_k<1><<<dim3(DM / 128, MTOK / 128), 256, 0, stream>>>(ff, w_down, x1, x1, MTOK, DM, DFF);
    rmsnorm_k<<<MTOK / 4, 256, 0, stream>>>(x1, fin_g, out);
}
```

```cpp
#include <hip/hip_runtime.h>
#include <cstdio>
#include <cstdint>
namespace pg8 {
#define PG8_LAS __attribute__((address_space(3)))
typedef unsigned short bf16_t;
typedef short bf16x8 __attribute__((ext_vector_type(8)));
typedef float f32x4 __attribute__((ext_vector_type(4)));
typedef unsigned u32x4 __attribute__((ext_vector_type(4)));
constexpr int BM = 256, BK = 64, HALF = 128, HTB = HALF * BK * 2  , STAGE_BYTES = 8 * HTB, NXCD = 8, WGM = 8;

__host__ __device__ __forceinline__ int lds_byte(int r, int c) { const int st = (r >> 4) * 2 + (c >> 5), rr = r & 15, cc = c & 31, ob = rr * 64 + cc * 2; return st * 1024 + (ob ^ (((ob >> 9) & 1) << 5)); }
__host__ __device__ __forceinline__ void stage_rc(int b, int& R, int& C) { const int st = b / 1024, sb = b % 1024, swz = sb ^ (((sb >> 9) & 1) << 5); R = (st >> 1) * 16 + swz / 64; C = (st & 1) * 32 + (swz % 64) / 2; }
__host__ __device__ __forceinline__ int perm32(int rho) { const int n = rho >> 4, i = rho & 15; return 8 * (i >> 2) + 4 * n + (i & 3); }

struct Unit { int pm, pn; };
struct Gemm { const bf16_t* A; const bf16_t* Bt; int M, N, K; };

struct StaticOrder {
    int nM, nN, nwg, G, c;
    __host__ __device__ void init(int M, int N, int G_, int c_) { nM = M / BM; nN = N / BM; nwg = nM * nN; G = G_; c = c_; }
    __host__ __device__ bool next(int i, Unit& u) const {
        const long L = (long)i * G + c; if (L >= nwg) return false;
        int wgid = (int)L; { const int q = nwg / NXCD, r = nwg % NXCD, xcd = wgid % NXCD, off = wgid / NXCD; wgid = (xcd < r ? xcd * (q + 1) : r * (q + 1) + (xcd - r) * q) + off; }
        const int nig = WGM * nN, gid = wgid / nig, fm = gid * WGM, gsz = (nM - fm) < WGM ? (nM - fm) : WGM;
        u.pm = fm + ((wgid % nig) % gsz); u.pn = (wgid % nig) / gsz; return true;
    }
    __device__ __forceinline__ void a_ready(const Unit&) const {}
    __device__ __forceinline__ void done(const Unit&) const {}
};

__device__ __forceinline__ unsigned cvt_pk_bf16(float lo, float hi) { unsigned r; asm volatile("v_cvt_pk_bf16_f32 %0, %1, %2" : "=v"(r) : "v"(lo), "v"(hi)); return r; }
typedef unsigned u32x2 __attribute__((ext_vector_type(2)));

struct EpiSplit {
    static constexpr bool PERM = true, AFTER_DRAIN = false;
    bf16_t* O; size_t split_stride; int qseg; float qscale;
    __device__ __forceinline__ void operator()(const f32x4 (&acc)[2][2][4][2], const Unit& u, int wr, int wc, int fr, int fq) const {
        const int row0 = u.pm * BM + wr * 64 + fr; int colt = u.pn * BM;
        const int t = colt >> 9; bf16_t* base = O + (size_t)t * split_stride; colt -= t << 9;
        const float sc = (t == qseg) ? qscale : 1.0f;
        const int col0 = colt + wc * 32 + 8 * fq;
#pragma unroll
        for (int ai = 0; ai < 2; ++ai)
#pragma unroll
            for (int m = 0; m < 4; ++m) { bf16_t* rowp = base + (size_t)(row0 + ai * HALF + m * 16) * 512 + col0;
#pragma unroll
                for (int bj = 0; bj < 2; ++bj) { f32x4 v0 = acc[ai][bj][m][0] * sc, v1 = acc[ai][bj][m][1] * sc;
                    u32x4 w; w.x = cvt_pk_bf16(v0[0], v0[1]); w.y = cvt_pk_bf16(v0[2], v0[3]); w.z = cvt_pk_bf16(v1[0], v1[1]); w.w = cvt_pk_bf16(v1[2], v1[3]);
                    *(u32x4*)(rowp + bj * HALF) = w; } }
    }
};
template <bool WITH_BF16> struct EpiRes {
    static constexpr bool PERM = false, AFTER_DRAIN = false;
    const float* base; float* out; bf16_t* xb; float* ssq;
    __device__ __forceinline__ void operator()(const f32x4 (&acc)[2][2][4][2], const Unit& u, int wr, int wc, int fr, int fq) const {
        const int col0 = u.pn * BM + wc * 32 + 4 * fq;
#pragma unroll
        for (int ai = 0; ai < 2; ++ai)
#pragma unroll
            for (int m = 0; m < 4; ++m) { const int r = u.pm * BM + ai * HALF + wr * 64 + m * 16 + fr; const size_t off = (size_t)r * 1024 + col0; float ss = 0.f;
#pragma unroll
                for (int bj = 0; bj < 2; ++bj)
#pragma unroll
                    for (int n = 0; n < 2; ++n) { const f32x4 bs = *(const f32x4*)(base + off + bj * HALF + n * 16); const f32x4 o = bs + acc[ai][bj][m][n];
                        *(f32x4*)(out + off + bj * HALF + n * 16) = o;
                        if (WITH_BF16) { u32x2 w; w.x = cvt_pk_bf16(o[0], o[1]); w.y = cvt_pk_bf16(o[2], o[3]); *(u32x2*)(xb + off + bj * HALF + n * 16) = w;
                            ss += (o[0] * o[0] + o[1] * o[1]) + (o[2] * o[2] + o[3] * o[3]); } }
                if (WITH_BF16) { ss += __shfl_xor(ss, 16); ss += __shfl_xor(ss, 32); if (fq == 0) ssq[(size_t)r * 16 + u.pn * 4 + wc] = ss; } }
    }
};
struct EpiSwiGLU {
    static constexpr bool PERM = true, AFTER_DRAIN = false;
    bf16_t* O; int ldc; const float* ssq; float eps;
    __device__ __forceinline__ void operator()(const f32x4 (&acc)[2][2][4][2], const Unit& u, int wr, int wc, int fr, int fq) const {
        const int row0 = u.pm * BM + wr * 64 + fr, col0 = u.pn * HALF + wc * 32 + 8 * fq;
#pragma unroll
        for (int ai = 0; ai < 2; ++ai)
#pragma unroll
            for (int m = 0; m < 4; ++m) { const int r = row0 + ai * HALF + m * 16;
                const f32x4* sp = (const f32x4*)(ssq + (size_t)r * 16); const f32x4 s0 = sp[0], s1 = sp[1], s2 = sp[2], s3 = sp[3];
                const float tot = ((s0[0] + s0[1]) + (s0[2] + s0[3])) + ((s1[0] + s1[1]) + (s1[2] + s1[3])) + ((s2[0] + s2[1]) + (s2[2] + s2[3])) + ((s3[0] + s3[1]) + (s3[2] + s3[3]));
                const float rs = rsqrtf(tot * (1.0f / 1024.0f) + eps);
                float o[8];
#pragma unroll
                for (int n = 0; n < 2; ++n)
#pragma unroll
                    for (int i = 0; i < 4; ++i) { const float g = acc[ai][0][m][n][i] * rs, up = acc[ai][1][m][n][i] * rs;
                        const float sg = __builtin_amdgcn_rcpf(1.0f + __builtin_amdgcn_exp2f(-1.4426950408889634f * g)); o[4 * n + i] = g * sg * up; }
                u32x4 w; w.x = cvt_pk_bf16(o[0], o[1]); w.y = cvt_pk_bf16(o[2], o[3]); w.z = cvt_pk_bf16(o[4], o[5]); w.w = cvt_pk_bf16(o[6], o[7]);
                *(u32x4*)(O + (size_t)r * ldc + col0) = w; }
    }
};

template <class Epi, class Sched, bool ALIGN_EPI = false, bool SP2 = false>
__device__ __forceinline__ void gemm_phase(PG8_LAS unsigned char* lds, const Gemm g, const Sched& S, const Epi& E) {
    const int tid = threadIdx.x, wid = __builtin_amdgcn_readfirstlane(tid >> 6), lane = tid & 63, wr = wid >> 2, wc = wid & 3, fr = lane & 15, fq = lane >> 4;
    const int K = g.K, nt = K / BK;
    unsigned voffA[2], voffB[2];
#pragma unroll
    for (int i = 0; i < 2; ++i) { int R, C; stage_rc(tid * 16 + i * 8192, R, C); const int Rb = Epi::PERM ? ((R & ~31) + perm32(R & 31)) : R;
        voffA[i] = (unsigned)(R * K + C) * 2u; voffB[i] = (unsigned)(Rb * K + C) * 2u; }
    const size_t kstep = (size_t)(BK * 2);
    const size_t hstep = (size_t)HALF * K * 2;
    const size_t tstep = 2 * hstep;
    const unsigned ldsw = (unsigned)wid * 1024u;
    const int aoff = lds_byte(wr * 64 + fr, fq * 8), boff = lds_byte(wc * 32 + fr, fq * 8);
#define PG8_SA(b, h) (((b) * 2 + (h)) * HTB)
#define PG8_SB(b, h) ((4 + (b) * 2 + (h)) * HTB)
#define PG8_STAGE(bufoff, gbase, voff) do { _Pragma("unroll") for (int _i = 0; _i < 2; ++_i) \
        __builtin_amdgcn_global_load_lds((const unsigned*)((const char*)(gbase) + (voff)[_i]), (PG8_LAS unsigned*)(lds + (bufoff) + ldsw + _i * 8192), 16, 0, 0); } while (0)
#define PG8_LDA(dst, b, h) do { _Pragma("unroll") for (int m = 0; m < 4; ++m) _Pragma("unroll") for (int k = 0; k < 2; ++k) dst[m][k] = *(const PG8_LAS bf16x8*)(lds + PG8_SA(b, h) + aoff + m * 2048 + k * 1024); } while (0)
#define PG8_LDB(dst, b, h) do { _Pragma("unroll") for (int n = 0; n < 2; ++n) _Pragma("unroll") for (int k = 0; k < 2; ++k) dst[n][k] = *(const PG8_LAS bf16x8*)(lds + PG8_SB(b, h) + boff + n * 2048 + k * 1024); } while (0)
#define PG8_MMA(ai, bj, At, Bt) do { __builtin_amdgcn_s_setprio(1); _Pragma("unroll") for (int m = 0; m < 4; ++m) _Pragma("unroll") for (int n = 0; n < 2; ++n) _Pragma("unroll") for (int k = 0; k < 2; ++k) \
        acc[ai][bj][m][n] = __builtin_amdgcn_mfma_f32_16x16x32_bf16(Bt[n][k], At[m][k], acc[ai][bj][m][n], 0, 0, 0); __builtin_amdgcn_s_setprio(0); } while (0)
#define PG8_WAIT_V(n) asm volatile("s_waitcnt vmcnt(" #n ")" ::: "memory")
#define PG8_WAIT_L(n) asm volatile("s_waitcnt lgkmcnt(" #n ")" ::: "memory")
#define PG8_BAR __builtin_amdgcn_s_barrier()
#define PG8_SCHED __builtin_amdgcn_sched_barrier(0)
    Unit cur, nxt; int ui = 0;
    if (!S.next(0, cur)) return;
    f32x4 acc[2][2][4][2];
#pragma unroll
    for (int a = 0; a < 2; ++a)
#pragma unroll
        for (int b = 0; b < 2; ++b)
#pragma unroll
            for (int m = 0; m < 4; ++m)
#pragma unroll
                for (int n = 0; n < 2; ++n) acc[a][b][m][n] = (f32x4){0.f, 0.f, 0.f, 0.f};
    bf16x8 At[4][2], B0[2][2], B1[2][2];
    const char* cA = (const char*)g.A + (size_t)cur.pm * tstep; const char* cB = (const char*)g.Bt + (size_t)cur.pn * tstep;
    S.a_ready(cur);
    if constexpr (SP2) {
        PG8_STAGE(PG8_SB(0, 0), cB, voffB); PG8_STAGE(PG8_SB(0, 1), cB + hstep, voffB); PG8_STAGE(PG8_SA(0, 0), cA, voffA); PG8_STAGE(PG8_SA(0, 1), cA + hstep, voffA);
        if (wr == 1) PG8_BAR;
        PG8_WAIT_V(2); PG8_BAR;
        PG8_STAGE(PG8_SB(1, 0), cB + kstep, voffB); PG8_STAGE(PG8_SA(1, 0), cA + kstep, voffA); PG8_STAGE(PG8_SB(1, 1), cB + hstep + kstep, voffB);
        PG8_WAIT_V(6); PG8_BAR;
    } else {
        PG8_STAGE(PG8_SB(0, 0), cB, voffB); PG8_STAGE(PG8_SA(0, 0), cA, voffA); PG8_STAGE(PG8_SB(0, 1), cB + hstep, voffB); PG8_STAGE(PG8_SA(0, 1), cA + hstep, voffA);
        if (wr == 1) PG8_BAR;
        PG8_WAIT_V(4); PG8_BAR;
        PG8_STAGE(PG8_SB(1, 0), cB + kstep, voffB); PG8_STAGE(PG8_SA(1, 0), cA + kstep, voffA); PG8_STAGE(PG8_SB(1, 1), cB + hstep + kstep, voffB);
        PG8_WAIT_V(6); PG8_BAR;
    }
    for (;;) {
        const bool has_next = S.next(ui + 1, nxt);
        const char* nA = has_next ? (const char*)g.A + (size_t)nxt.pm * tstep : cA; const char* nB = has_next ? (const char*)g.Bt + (size_t)nxt.pn * tstep : cB;
        for (int t = 0; t < nt; t += 2) {
            const bool last = (t == nt - 2);
            const char* a1 = cA + (size_t)(t + 1) * kstep;
            const char* a2 = last ? nA : cA + (size_t)(t + 2) * kstep; const char* b2 = last ? nB : cB + (size_t)(t + 2) * kstep;
            const char* a3 = a2 + kstep; const char* b3 = b2 + kstep;
            if (last && has_next) S.a_ready(nxt);
            if constexpr (SP2) {
            PG8_LDB(B0, 0, 0); PG8_LDB(B1, 0, 1); PG8_SCHED; PG8_LDA(At, 0, 0); PG8_STAGE(PG8_SA(1, 1), a1 + hstep, voffA);
            PG8_WAIT_V(8); PG8_WAIT_L(0); PG8_BAR; PG8_MMA(0, 0, At, B0); PG8_MMA(0, 1, At, B1); PG8_BAR; PG8_SCHED;
            PG8_LDA(At, 0, 1); PG8_STAGE(PG8_SB(0, 0), b2, voffB); PG8_STAGE(PG8_SB(0, 1), b2 + hstep, voffB); PG8_STAGE(PG8_SA(0, 0), a2, voffA);
            PG8_WAIT_V(8); PG8_WAIT_L(0); PG8_BAR; PG8_MMA(1, 0, At, B0); PG8_MMA(1, 1, At, B1); PG8_BAR; PG8_SCHED;
            PG8_LDB(B0, 1, 0); PG8_LDB(B1, 1, 1); PG8_SCHED; PG8_LDA(At, 1, 0); PG8_STAGE(PG8_SA(0, 1), a2 + hstep, voffA);
            PG8_WAIT_V(8); PG8_WAIT_L(0); PG8_BAR; PG8_MMA(0, 0, At, B0); PG8_MMA(0, 1, At, B1); PG8_BAR; PG8_SCHED;
            PG8_LDA(At, 1, 1); PG8_STAGE(PG8_SB(1, 0), b3, voffB); PG8_STAGE(PG8_SB(1, 1), b3 + hstep, voffB); PG8_STAGE(PG8_SA(1, 0), a3, voffA);
            PG8_WAIT_V(8); PG8_WAIT_L(0); PG8_BAR; PG8_MMA(1, 0, At, B0); PG8_MMA(1, 1, At, B1); PG8_BAR; PG8_SCHED;
            } else {
            PG8_LDB(B0, 0, 0); PG8_SCHED; PG8_LDA(At, 0, 0); PG8_STAGE(PG8_SA(1, 1), a1 + hstep, voffA);
            PG8_WAIT_L(8); PG8_BAR; PG8_WAIT_L(0); PG8_MMA(0, 0, At, B0); PG8_BAR; PG8_SCHED;
            PG8_LDB(B1, 0, 1); PG8_STAGE(PG8_SB(0, 0), b2, voffB);
            PG8_BAR; PG8_WAIT_L(0); PG8_MMA(0, 1, At, B1); PG8_BAR;
            PG8_LDA(At, 0, 1); PG8_STAGE(PG8_SA(0, 0), a2, voffA);
            PG8_BAR; PG8_WAIT_L(0); PG8_MMA(1, 0, At, B0); PG8_BAR; PG8_SCHED;
            PG8_STAGE(PG8_SB(0, 1), b2 + hstep, voffB);
            PG8_WAIT_V(6); PG8_BAR; PG8_MMA(1, 1, At, B1); PG8_BAR;
            PG8_LDB(B0, 1, 0); PG8_SCHED; PG8_LDA(At, 1, 0); PG8_STAGE(PG8_SA(0, 1), a2 + hstep, voffA);
            PG8_WAIT_L(8); PG8_BAR; PG8_WAIT_L(0); PG8_MMA(0, 0, At, B0); PG8_BAR; PG8_SCHED;
            PG8_LDB(B1, 1, 1); PG8_STAGE(PG8_SB(1, 0), b3, voffB);
            PG8_BAR; PG8_WAIT_L(0); PG8_MMA(0, 1, At, B1); PG8_BAR;
            PG8_LDA(At, 1, 1); PG8_STAGE(PG8_SA(1, 0), a3, voffA);
            PG8_BAR; PG8_WAIT_L(0); PG8_MMA(1, 0, At, B0); PG8_BAR; PG8_SCHED;
            PG8_STAGE(PG8_SB(1, 1), b3 + hstep, voffB);
            PG8_WAIT_V(6); PG8_BAR; PG8_MMA(1, 1, At, B1); PG8_BAR;
            }
        }
        if constexpr (ALIGN_EPI) { if (wr == 0) PG8_BAR; }
        if constexpr (!Epi::AFTER_DRAIN) { E(acc, cur, wr, wc, fr, fq); S.done(cur); }
        if (!has_next) break;
#pragma unroll
        for (int a = 0; a < 2; ++a)
#pragma unroll
            for (int b = 0; b < 2; ++b)
#pragma unroll
                for (int m = 0; m < 4; ++m)
#pragma unroll
                    for (int n = 0; n < 2; ++n) acc[a][b][m][n] = (f32x4){0.f, 0.f, 0.f, 0.f};
        cur = nxt; cA = nA; cB = nB; ++ui;
        if constexpr (ALIGN_EPI) { if (wr == 1) PG8_BAR; }
    }
    PG8_WAIT_V(0);
    if constexpr (!ALIGN_EPI) { if (wr == 0) PG8_BAR; }
    PG8_BAR;
    if constexpr (Epi::AFTER_DRAIN) { E.fused(acc, cur, wr, wc, fr, fq, lds, wid, lane); S.done(cur); }
#undef PG8_SA
#undef PG8_SB
#undef PG8_STAGE
#undef PG8_LDA
#undef PG8_LDB
#undef PG8_MMA
#undef PG8_WAIT_V
#undef PG8_WAIT_L
#undef PG8_BAR
#undef PG8_SCHED
}
}
#ifndef PG8_SP2
#define PG8_SP2 true
#endif
#ifndef PG8_ALIGN
#define PG8_ALIGN true
#endif
constexpr int NWAVES = 8;
constexpr int DM = 1024, NB = 16, SEQ = 2048, M = NB * SEQ, INC = 3584, DFF = 2816, NH = 8, HD = 64;
constexpr float EPS = 1e-6f;
constexpr float QSCALE = 0.125f * 1.4426950408889634f;
constexpr size_t MiB = 1u << 20;
constexpr size_t WS_CTL = 0, CTL_ZERO_BYTES = 64 * 1024;
constexpr size_t WS_WIN = 1 * MiB, WS_WOUT = 8 * MiB, WS_WGU = 10 * MiB, WS_WD = 21 * MiB;
constexpr size_t WS_SSQ2 = 27 * MiB;
constexpr size_t WS_XB = 32 * MiB;
constexpr size_t WS_PROJ = 96 * MiB, SEG_ELEMS = (size_t)M * 512;
constexpr size_t WS_FF = 96 * MiB;
constexpr size_t WS_MIX = 320 * MiB;
constexpr size_t WS_X1 = 384 * MiB, WS_END = 512 * MiB;
constexpr int CW_BAR = 4096;
constexpr int RING_OFF = 0, RING_BYTES = 131072;
constexpr int LDSCTL_OFF = RING_BYTES, MISC_OFF = LDSCTL_OFF + 320;
constexpr int LDS_BYTES = 147456;
#define GAS __attribute__((address_space(1)))
#define LAS __attribute__((address_space(3)))
typedef unsigned short bf16;
typedef unsigned v4u __attribute__((ext_vector_type(4)));
typedef float f32x4 __attribute__((ext_vector_type(4)));
typedef short bf16x8 __attribute__((ext_vector_type(8)));
typedef GAS unsigned gu32;
typedef GAS unsigned long long gu64;
#define RLX_AGENT __ATOMIC_RELAXED, __HIP_MEMORY_SCOPE_AGENT
#define LDS_WAIT() asm volatile("s_waitcnt lgkmcnt(0)" ::: "memory")
#define VM_WAIT() asm volatile("s_waitcnt vmcnt(0)" ::: "memory")
__device__ __forceinline__ unsigned long long rt() { return __builtin_amdgcn_s_memrealtime(); }
__device__ __forceinline__ unsigned f2bf(float f) { unsigned u = __builtin_bit_cast(unsigned, f); return (u + 0x7fffu + ((u >> 16) & 1u)) >> 16; }
__device__ __forceinline__ unsigned pk2(float lo, float hi) { return f2bf(lo) | (f2bf(hi) << 16); }

#define XB_TMO      128
#define XB_XCNT(j)  (256  + 64 * (j))
#define XB_XSUB(j)  (1280 + 64 * (j))
#define XB_XGEN(j)  (2304 + 64 * (j))
#define XB_TOP      3328
#define XB_TOPGEN   3392
#define XCD_BAR_WORDS 3456
#define XB_SPIN_CAP (1u << 18)

__device__ __forceinline__ unsigned xb_ld(unsigned* p)              { return __hip_atomic_load(p, __ATOMIC_RELAXED, __HIP_MEMORY_SCOPE_AGENT); }
__device__ __forceinline__ unsigned xb_add(unsigned* p, unsigned v) { return __hip_atomic_fetch_add(p, v, __ATOMIC_RELAXED, __HIP_MEMORY_SCOPE_AGENT); }
__device__ __forceinline__ unsigned xb_xcc_id() { return (unsigned)__builtin_amdgcn_s_getreg((3 << 11) | 20) & 0xFu; }
#define XB_SPIN(cond, bar) do { unsigned _sp = 0; while (cond) { __builtin_amdgcn_s_sleep(1); \
    if ((++_sp & 255u) == 0u) { if (xb_ld(&(bar)[XB_TMO])) break; if (_sp > XB_SPIN_CAP) { atomicAdd(&(bar)[XB_TMO], 1u); break; } } } } while (0)

struct XcdBarrier {
    unsigned* bar; unsigned x;
    volatile LAS unsigned* st;
};

__device__ __forceinline__ XcdBarrier xcd_barrier_post(unsigned* bar, volatile LAS unsigned* st) {
    XcdBarrier b; b.bar = bar; b.x = xb_xcc_id(); b.st = st;
    if (threadIdx.x == 0) (void)xb_add(&bar[XB_XCNT(b.x)], 1u);
    return b;
}
__device__ __forceinline__ void xcd_barrier_complete(unsigned* bar, unsigned x, unsigned& nloc, unsigned& nx) {
    const unsigned G = gridDim.x * gridDim.y * gridDim.z;
    unsigned sum, cnt, mine, sp = 0u;
    for (;;) {
        sum = 0u; cnt = 0u; mine = 0u;
#pragma unroll
        for (unsigned j = 0; j < 16; ++j) { const unsigned c = xb_ld(&bar[XB_XCNT(j)]); sum += c; cnt += (c > 0u) ? 1u : 0u; mine = (j == x) ? c : mine; }
        if (sum == G) break;
        __builtin_amdgcn_s_sleep(1);
        if ((++sp & 255u) == 0u) { if (xb_ld(&bar[XB_TMO])) break; if (sp > XB_SPIN_CAP) { atomicAdd(&bar[XB_TMO], 1u); break; } }
    }
    nloc = mine > 0u ? mine : 1u; nx = cnt > 0u ? cnt : 1u;
}

__device__ __forceinline__ void xcd_barrier(const XcdBarrier& b) {
    asm volatile("s_waitcnt vmcnt(0)" ::: "memory");
    __syncthreads();
    if (threadIdx.x == 0) {
        unsigned* bar = b.bar;
        __builtin_amdgcn_s_waitcnt(0);
        unsigned nloc = b.st[0], nx = b.st[1];
        if (nloc == 0u) { xcd_barrier_complete(bar, b.x, nloc, nx); b.st[0] = nloc; b.st[1] = nx; }
        const unsigned old = xb_add(&bar[XB_XSUB(b.x)], 1u);
        const unsigned gen = old / nloc;
        if (old + 1u == (gen + 1u) * nloc) {
            __builtin_amdgcn_fence(__ATOMIC_RELEASE, "agent");
            asm volatile("s_waitcnt vmcnt(0)" ::: "memory");
            const unsigned og = xb_add(&bar[XB_TOP], 1u);
            const unsigned tg = og / nx;
            if (og + 1u == (tg + 1u) * nx) xb_add(&bar[XB_TOPGEN], 1u);
            else XB_SPIN(xb_ld(&bar[XB_TOPGEN]) == tg, bar);
            __builtin_amdgcn_fence(__ATOMIC_ACQUIRE, "agent");
            xb_add(&bar[XB_XGEN(b.x)], 1u);
            asm volatile("s_waitcnt vmcnt(0)" ::: "memory");
        } else {
            XB_SPIN(xb_ld(&bar[XB_XGEN(b.x)]) == gen, bar);
            __builtin_amdgcn_fence(__ATOMIC_ACQUIRE, "agent");
            asm volatile("s_waitcnt vmcnt(0)" ::: "memory");
        }
    }
    __syncthreads();
}
struct Args { const float* in[12]; float* out; unsigned char* ws; };
__device__ __forceinline__ float wave_sum(float v) {
#pragma unroll
    for (int o = 1; o < 64; o <<= 1) v += __shfl_xor(v, o);
    return v;
}
__device__ __forceinline__ float bf2f(unsigned short b) { return __builtin_bit_cast(float, (unsigned)b << 16); }

__device__ __forceinline__ void p0_transpose_item(const float* W, int K, int N, bf16* WT, int drow0, const float* gk, LAS float* scr, int k0, int n0, int lane) {
#pragma unroll 8
    for (int i = 0; i < 32; ++i) { const int kk = 2 * i + (lane >> 5); float v = W[(size_t)(k0 + kk) * N + n0 + (lane & 31)]; if (gk) v *= gk[k0 + kk]; scr[kk * 33 + (lane & 31)] = v; }
    LDS_WAIT(); asm volatile("" ::: "memory");
    const int c = lane & 7;
#pragma unroll
    for (int j = 0; j < 4; ++j) { const int n = (lane >> 3) + 8 * j; const LAS float* s = scr + (8 * c) * 33 + n;
        v4u o; o.x = pk2(s[0 * 33], s[1 * 33]); o.y = pk2(s[2 * 33], s[3 * 33]); o.z = pk2(s[4 * 33], s[5 * 33]); o.w = pk2(s[6 * 33], s[7 * 33]);
        *(GAS v4u*)(WT + (size_t)(drow0 + n) * K + k0 + 8 * c) = o; }
    LDS_WAIT(); asm volatile("" ::: "memory");
}
__device__ __forceinline__ void rms_row_to_bf16(const float* xrow, bf16* orow, int lane) {
    const GAS f32x4* xr = (const GAS f32x4*)xrow + lane;
    f32x4 v[4]; float s = 0.f;
#pragma unroll
    for (int j = 0; j < 4; ++j) { v[j] = xr[64 * j]; s += (v[j].x * v[j].x + v[j].y * v[j].y) + (v[j].z * v[j].z + v[j].w * v[j].w); }
    const float rstd = rsqrtf(wave_sum(s) * (1.f / DM) + EPS);
    GAS unsigned long long* o8 = (GAS unsigned long long*)orow + lane;
#pragma unroll
    for (int j = 0; j < 4; ++j) o8[64 * j] = (unsigned long long)pk2(v[j].x * rstd, v[j].y * rstd) | ((unsigned long long)pk2(v[j].z * rstd, v[j].w * rstd) << 32);
}
__device__ __forceinline__ void rms_row_inplace(float* xrow, const float* g, int lane) {
    GAS f32x4* xr = (GAS f32x4*)xrow + lane;
    f32x4 v[4]; float s = 0.f;
#pragma unroll
    for (int j = 0; j < 4; ++j) { v[j] = xr[64 * j]; s += (v[j].x * v[j].x + v[j].y * v[j].y) + (v[j].z * v[j].z + v[j].w * v[j].w); }
    const float rstd = rsqrtf(wave_sum(s) * (1.f / DM) + EPS);
#pragma unroll
    for (int j = 0; j < 4; ++j) { const f32x4 gv = ((const GAS f32x4*)g)[lane + 64 * j]; xr[64 * j] = v[j] * rstd * gv; }
}
__device__ __forceinline__ float sigmoid_f(float x) { return 1.0f / (1.0f + __expf(-x)); }
__device__ __forceinline__ void hgrn_naive_task(int bh, const bf16* HQ, const bf16* HF, const bf16* HI, const bf16* HGt, const float* lbnd, const float* ng, bf16* mixed, LAS unsigned char* lds, int tid) {
    constexpr int TS = 8;
    LAS float* st = (LAS float*)lds;
    LAS float* part = st + 4 * TS * 64;
    const int b = bh >> 3, h = bh & 7, e = tid & 63, dg = tid >> 6;
    float lb[8], S[8];
#pragma unroll
    for (int i = 0; i < 8; ++i) { const int d = h * 64 + dg * 8 + i; const float l0 = lbnd[d], l1 = lbnd[512 + d]; lb[i] = 1.0f / (1.0f + __expf(l1 - l0)); S[i] = 0.f; }
    const float g = ng[h * 64 + e];
    for (int t0 = 0; t0 < SEQ; t0 += TS) {
        __syncthreads();
        { const size_t off = (size_t)(b * SEQ + t0 + dg) * 512 + h * 64 + e;
          st[(0 * TS + dg) * 64 + e] = bf2f(HQ[off]); st[(1 * TS + dg) * 64 + e] = bf2f(HF[off]); st[(2 * TS + dg) * 64 + e] = bf2f(HI[off]); st[(3 * TS + dg) * 64 + e] = bf2f(HGt[off]); }
        __syncthreads();
#pragma unroll
        for (int s = 0; s < TS; ++s) { const float ve = st[(2 * TS + s) * 64 + e]; float po = 0.f;
#pragma unroll
            for (int i = 0; i < 8; ++i) { const float fl = st[(1 * TS + s) * 64 + dg * 8 + i], q = st[(0 * TS + s) * 64 + dg * 8 + i];
                const float f = lb[i] + (1.0f - lb[i]) * sigmoid_f(fl); S[i] = f * S[i] + (1.0f - f) * ve; po = fmaf(S[i], q, po); }
            part[(s * 8 + dg) * 64 + e] = po; }
        __syncthreads();
        { const int s = dg; float o = 0.f;
#pragma unroll
          for (int gq = 0; gq < 8; ++gq) o += part[(s * 8 + gq) * 64 + e];
          const float ms = wave_sum(o * o) * (1.0f / 64.0f); const float gt = st[(3 * TS + s) * 64 + e];
          const float y = o * rsqrtf(ms + EPS) * g * (gt * sigmoid_f(gt));
          mixed[(size_t)(b * SEQ + t0 + s) * DM + h * 64 + e] = (bf16)f2bf(y); }
    }
    __syncthreads();
}
__device__ __forceinline__ void sb_naive_task(int bh, int qb, const bf16* SQ, const bf16* SK, const bf16* SV, const float* ng, bf16* mixed, LAS unsigned char* wl, int lane) {
    LAS unsigned short* Ks = (LAS unsigned short*)wl;
    LAS unsigned short* Vs = Ks + 4096;
    const int b = bh >> 3, h = bh & 7, tq = qb * 64 + lane;
    float q[64], o[64];
    { const GAS v4u* qp = (const GAS v4u*)(SQ + (size_t)(b * SEQ + tq) * 512 + h * 64);
#pragma unroll
      for (int c = 0; c < 8; ++c) { const v4u w = qp[c];
#pragma unroll
          for (int i = 0; i < 4; ++i) { q[c * 8 + 2 * i] = __builtin_bit_cast(float, w[i] << 16); q[c * 8 + 2 * i + 1] = __builtin_bit_cast(float, w[i] & 0xffff0000u); } }
#pragma unroll
      for (int d = 0; d < 64; ++d) o[d] = 0.f; }
    float A = 0.f;
    for (int kt = qb; kt >= 0; --kt) {
        asm volatile("s_waitcnt lgkmcnt(0)" ::: "memory");
#pragma unroll
        for (int j = 0; j < 8; ++j) { const int c = lane + 64 * j, row = c >> 3, ch = c & 7; const size_t off = (size_t)(b * SEQ + kt * 64 + row) * 512 + h * 64 + ch * 8;
            *(LAS v4u*)(Ks + row * 64 + ch * 8) = *(const GAS v4u*)(SK + off); *(LAS v4u*)(Vs + row * 64 + ch * 8) = *(const GAS v4u*)(SV + off); }
        asm volatile("s_waitcnt lgkmcnt(0)" ::: "memory");
        for (int j = 63; j >= 0; --j) {
            const int s = kt * 64 + j; float z = 0.f;
#pragma unroll
            for (int c = 0; c < 8; ++c) { const v4u w = *(const LAS v4u*)(Ks + j * 64 + c * 8);
#pragma unroll
                for (int i = 0; i < 4; ++i) { z = fmaf(q[c * 8 + 2 * i], __builtin_bit_cast(float, w[i] << 16), z); z = fmaf(q[c * 8 + 2 * i + 1], __builtin_bit_cast(float, w[i] & 0xffff0000u), z); } }
            const bool act = s < tq;
            const float c2 = act ? (fmaxf(z, 0.f) + __builtin_amdgcn_logf(1.0f + __builtin_amdgcn_exp2f(-fabsf(z)))) : 0.f;
            const float w2 = act ? __builtin_amdgcn_exp2f(z - c2 - A) : 0.f;
            A += c2;
#pragma unroll
            for (int c = 0; c < 8; ++c) { const v4u w = *(const LAS v4u*)(Vs + j * 64 + c * 8);
#pragma unroll
                for (int i = 0; i < 4; ++i) { o[c * 8 + 2 * i] = fmaf(w2, __builtin_bit_cast(float, w[i] << 16), o[c * 8 + 2 * i]); o[c * 8 + 2 * i + 1] = fmaf(w2, __builtin_bit_cast(float, w[i] & 0xffff0000u), o[c * 8 + 2 * i + 1]); } }
        }
    }
    float ss = 0.f;
#pragma unroll
    for (int d = 0; d < 64; ++d) ss = fmaf(o[d], o[d], ss);
    const float r = rsqrtf(ss * (1.0f / 64.0f) + EPS);
    GAS v4u* op = (GAS v4u*)(mixed + (size_t)(b * SEQ + tq) * DM + 512 + h * 64);
#pragma unroll
    for (int c = 0; c < 8; ++c) { v4u w;
#pragma unroll
        for (int i = 0; i < 4; ++i) { const int d = c * 8 + 2 * i; w[i] = pk2(o[d] * r * ng[h * 64 + d], o[d + 1] * r * ng[h * 64 + d + 1]); }
        op[c] = w; }
}
__global__ void __launch_bounds__(NWAVES * 64, 2) mega_fwd(Args args) {
    extern __shared__ __attribute__((aligned(16))) unsigned char lds_raw[];
    LAS unsigned char* lds = (LAS unsigned char*)lds_raw;
    volatile LAS unsigned* MISC = (volatile LAS unsigned*)(lds + MISC_OFF);
    const int tid = threadIdx.x, lane = tid & 63, wave = __builtin_amdgcn_readfirstlane(tid >> 6);
    const int G = gridDim.x; const int bx = blockIdx.x; const int vcu = (G % 8 == 0) ? (bx % 8) * (G / 8) + bx / 8 : bx;
    unsigned char* ws = args.ws;
    gu32* ctl = (gu32*)(ws + WS_CTL);
    const float* x = args.in[0]; const float* mix_g = args.in[1]; const float* w_in = args.in[2]; const float* lbnd = args.in[3]; const float* hgrn_g = args.in[4]; const float* sb_g = args.in[5];
    const float* w_out = args.in[6]; const float* ffn_g = args.in[7]; const float* w_gate = args.in[8]; const float* w_up = args.in[9]; const float* w_down = args.in[10]; const float* fin_g = args.in[11];
    float* out = args.out;
    bf16* Win_t = (bf16*)(ws + WS_WIN); bf16* Wout_t = (bf16*)(ws + WS_WOUT); bf16* Wgu_t = (bf16*)(ws + WS_WGU); bf16* Wd_t = (bf16*)(ws + WS_WD);
    float* SSQ2 = (float*)(ws + WS_SSQ2); bf16* XB = (bf16*)(ws + WS_XB); bf16* PROJ = (bf16*)(ws + WS_PROJ); bf16* FF = (bf16*)(ws + WS_FF); bf16* MIX = (bf16*)(ws + WS_MIX); float* X1 = (float*)(ws + WS_X1);
    for (int u = tid; u < (LDS_BYTES - LDSCTL_OFF) / 4; u += NWAVES * 64) ((LAS unsigned*)(lds + LDSCTL_OFF))[u] = 0u;
    __syncthreads();
    XcdBarrier bar = xcd_barrier_post((unsigned*)(ctl + CW_BAR), MISC + 8);
    const int gw = vcu * NWAVES + wave, NGW = G * NWAVES;

    {
        LAS float* scr = (LAS float*)(lds + RING_OFF + wave * 16384);
        constexpr int I_IN = (DM / 64) * (INC / 32), I_OUT = (DM / 64) * (DM / 32), I_G = (DM / 64) * (DFF / 32), I_D = (DFF / 64) * (DM / 32);
        constexpr int NITEMS = I_IN + I_OUT + 2 * I_G + I_D;
        for (int it = gw; it < NITEMS; it += NGW) {
            int r = it;
            if (r < I_IN) { const int nblk = INC / 32, k0 = 64 * (r / nblk), n0 = 32 * (r % nblk); p0_transpose_item(w_in, DM, INC, Win_t, n0, mix_g, scr, k0, n0, lane); continue; } r -= I_IN;
            if (r < I_OUT) { const int nblk = DM / 32, k0 = 64 * (r / nblk), n0 = 32 * (r % nblk); p0_transpose_item(w_out, DM, DM, Wout_t, n0, nullptr, scr, k0, n0, lane); continue; } r -= I_OUT;
            if (r < I_G) { const int nblk = DFF / 32, k0 = 64 * (r / nblk), n0 = 32 * (r % nblk); p0_transpose_item(w_gate, DM, DFF, Wgu_t, 256 * (n0 >> 7) + (n0 & 127), ffn_g, scr, k0, n0, lane); continue; } r -= I_G;
            if (r < I_G) { const int nblk = DFF / 32, k0 = 64 * (r / nblk), n0 = 32 * (r % nblk); p0_transpose_item(w_up, DM, DFF, Wgu_t, 256 * (n0 >> 7) + 128 + (n0 & 127), ffn_g, scr, k0, n0, lane); continue; } r -= I_G;
            { const int nblk = DM / 32, k0 = 64 * (r / nblk), n0 = 32 * (r % nblk); p0_transpose_item(w_down, DFF, DM, Wd_t, n0, nullptr, scr, k0, n0, lane); }
        }
        for (int m = gw; m < M; m += NGW) rms_row_to_bf16(x + (size_t)m * DM, XB + (size_t)m * DM, lane);
    }
    xcd_barrier(bar);
    { pg8::Gemm g{XB, Win_t, M, INC, DM}; pg8::StaticOrder S; S.init(M, INC, G, bx);
      pg8::EpiSplit E{PROJ, SEG_ELEMS, 4, QSCALE};
      pg8::gemm_phase<pg8::EpiSplit, pg8::StaticOrder, PG8_ALIGN, PG8_SP2>(lds + RING_OFF, g, S, E); }
    xcd_barrier(bar);
    {
        const bf16* HQ = PROJ; const bf16* HF = PROJ + SEG_ELEMS; const bf16* HI = PROJ + 2 * SEG_ELEMS; const bf16* HGt = PROJ + 3 * SEG_ELEMS;
        const bf16* SQ = PROJ + 4 * SEG_ELEMS; const bf16* SK = PROJ + 5 * SEG_ELEMS; const bf16* SV = PROJ + 6 * SEG_ELEMS;
        for (int bh = vcu; bh < NB * NH; bh += G) hgrn_naive_task(bh, HQ, HF, HI, HGt, lbnd, hgrn_g, MIX, lds + RING_OFF, tid);
        for (int p = gw; p < NB * NH * 16; p += NGW) { const int bh = p >> 4, s = p & 15;
            sb_naive_task(bh, s, SQ, SK, SV, sb_g, MIX, lds + RING_OFF + wave * 16384, lane);
            sb_naive_task(bh, 31 - s, SQ, SK, SV, sb_g, MIX, lds + RING_OFF + wave * 16384, lane); }
    }
    xcd_barrier(bar);
    { pg8::Gemm g{MIX, Wout_t, M, DM, DM}; pg8::StaticOrder S; S.init(M, DM, G, bx);
      pg8::EpiRes<true> E{x, X1, XB, SSQ2};
      pg8::gemm_phase<pg8::EpiRes<true>, pg8::StaticOrder, PG8_ALIGN, PG8_SP2>(lds + RING_OFF, g, S, E); }
    xcd_barrier(bar);
    { pg8::Gemm g{XB, Wgu_t, M, 2 * DFF, DM}; pg8::StaticOrder S; S.init(M, 2 * DFF, G, bx);
      pg8::EpiSwiGLU E{FF, DFF, SSQ2, EPS};
      pg8::gemm_phase<pg8::EpiSwiGLU, pg8::StaticOrder, PG8_ALIGN, PG8_SP2>(lds + RING_OFF, g, S, E); }
    xcd_barrier(bar);
    { pg8::Gemm g{FF, Wd_t, M, DM, DFF}; pg8::StaticOrder S; S.init(M, DM, G, bx);
      pg8::EpiRes<false> E{X1, out, nullptr, nullptr};
      pg8::gemm_phase<pg8::EpiRes<false>, pg8::StaticOrder, PG8_ALIGN, PG8_SP2>(lds + RING_OFF, g, S, E); }
    xcd_barrier(bar);
    for (int m = gw; m < M; m += NGW) rms_row_inplace(out + (size_t)m * DM, fin_g, lane);
}

extern "C" void kernel_launch(void* const* d_in, const int* in_sizes, int n_in, void* d_out, int out_size, void* d_ws, size_t ws_size, hipStream_t stream) {
    static int grid = 0;
    if (grid == 0) {
        if (n_in != 12 || in_sizes[0] != M * DM || out_size != M * DM || ws_size < WS_END) { fprintf(stderr, "kernel_launch: unexpected shapes (n_in %d, in0 %d, out %d, ws %zu)\n", n_in, n_in > 0 ? in_sizes[0] : -1, out_size, ws_size); grid = -1; return; }
        int dev = 0, cus = 0;
        if (hipGetDevice(&dev) != hipSuccess || hipDeviceGetAttribute(&cus, hipDeviceAttributeMultiprocessorCount, dev) != hipSuccess) { grid = -1; return; }
        if (hipFuncSetAttribute((const void*)mega_fwd, hipFuncAttributeMaxDynamicSharedMemorySize, LDS_BYTES) != hipSuccess) { fprintf(stderr, "kernel_launch: hipFuncSetAttribute failed\n"); grid = -1; return; }
        (void)hipGetLastError();
        grid = cus;
    }
    if (grid < 0) return;
    (void)hipMemsetAsync((char*)d_ws + WS_CTL, 0, CTL_ZERO_BYTES, stream);
    Args a{};
    for (int i = 0; i < 12; ++i) a.in[i] = (const float*)d_in[i];
    a.out = (float*)d_out; a.ws = (unsigned char*)d_ws;
    hipLaunchKernelGGL(mega_fwd, dim3(grid), dim3(NWAVES * 64), LDS_BYTES, stream, a);
}
```

```cpp
#include <hip/hip_runtime.h>
#include <cstdio>
#include <cstdint>
namespace pg8 {
#define PG8_LAS __attribute__((address_space(3)))
typedef unsigned short bf16_t;
typedef short bf16x8 __attribute__((ext_vector_type(8)));
typedef float f32x4 __attribute__((ext_vector_type(4)));
typedef unsigned u32x4 __attribute__((ext_vector_type(4)));
constexpr int BM = 256, BK = 64, HALF = 128, HTB = HALF * BK * 2  , STAGE_BYTES = 8 * HTB, NXCD = 8, WGM = 8;

__host__ __device__ __forceinline__ int lds_byte(int r, int c) { const int st = (r >> 4) * 2 + (c >> 5), rr = r & 15, cc = c & 31, ob = rr * 64 + cc * 2; return st * 1024 + (ob ^ (((ob >> 9) & 1) << 5)); }
__host__ __device__ __forceinline__ void stage_rc(int b, int& R, int& C) { const int st = b / 1024, sb = b % 1024, swz = sb ^ (((sb >> 9) & 1) << 5); R = (st >> 1) * 16 + swz / 64; C = (st & 1) * 32 + (swz % 64) / 2; }
__host__ __device__ __forceinline__ int perm32(int rho) { const int n = rho >> 4, i = rho & 15; return 8 * (i >> 2) + 4 * n + (i & 3); }

struct Unit { int pm, pn; };
struct Gemm { const bf16_t* A; const bf16_t* Bt; int M, N, K; };

struct StaticOrder {
    int nM, nN, nwg, G, c;
    __host__ __device__ void init(int M, int N, int G_, int c_) { nM = M / BM; nN = N / BM; nwg = nM * nN; G = G_; c = c_; }
    __host__ __device__ bool next(int i, Unit& u) const {
        const long L = (long)i * G + c; if (L >= nwg) return false;
        int wgid = (int)L; { const int q = nwg / NXCD, r = nwg % NXCD, xcd = wgid % NXCD, off = wgid / NXCD; wgid = (xcd < r ? xcd * (q + 1) : r * (q + 1) + (xcd - r) * q) + off; }
        const int nig = WGM * nN, gid = wgid / nig, fm = gid * WGM, gsz = (nM - fm) < WGM ? (nM - fm) : WGM;
        u.pm = fm + ((wgid % nig) % gsz); u.pn = (wgid % nig) / gsz; return true;
    }
    __device__ __forceinline__ void a_ready(const Unit&) const {}
    __device__ __forceinline__ void done(const Unit&) const {}
};

__device__ __forceinline__ unsigned cvt_pk_bf16(float lo, float hi) { unsigned r; asm volatile("v_cvt_pk_bf16_f32 %0, %1, %2" : "=v"(r) : "v"(lo), "v"(hi)); return r; }
typedef unsigned u32x2 __attribute__((ext_vector_type(2)));

struct EpiSplit {
    static constexpr bool PERM = true, AFTER_DRAIN = false;
    bf16_t* O; size_t split_stride; int qseg; float qscale;
    __device__ __forceinline__ void operator()(const f32x4 (&acc)[2][2][4][2], const Unit& u, int wr, int wc, int fr, int fq) const {
        const int row0 = u.pm * BM + wr * 64 + fr; int colt = u.pn * BM;
        const int t = colt >> 9; bf16_t* base = O + (size_t)t * split_stride; colt -= t << 9;
        const float sc = (t == qseg) ? qscale : 1.0f;
        const int col0 = colt + wc * 32 + 8 * fq;
#pragma unroll
        for (int ai = 0; ai < 2; ++ai)
#pragma unroll
            for (int m = 0; m < 4; ++m) { bf16_t* rowp = base + (size_t)(row0 + ai * HALF + m * 16) * 512 + col0;
#pragma unroll
                for (int bj = 0; bj < 2; ++bj) { f32x4 v0 = acc[ai][bj][m][0] * sc, v1 = acc[ai][bj][m][1] * sc;
                    u32x4 w; w.x = cvt_pk_bf16(v0[0], v0[1]); w.y = cvt_pk_bf16(v0[2], v0[3]); w.z = cvt_pk_bf16(v1[0], v1[1]); w.w = cvt_pk_bf16(v1[2], v1[3]);
                    *(u32x4*)(rowp + bj * HALF) = w; } }
    }
};
template <bool WITH_BF16> struct EpiRes {
    static constexpr bool PERM = false, AFTER_DRAIN = false;
    const float* base; float* out; bf16_t* xb; float* ssq;
    __device__ __forceinline__ void operator()(const f32x4 (&acc)[2][2][4][2], const Unit& u, int wr, int wc, int fr, int fq) const {
        const int col0 = u.pn * BM + wc * 32 + 4 * fq;
#pragma unroll
        for (int ai = 0; ai < 2; ++ai)
#pragma unroll
            for (int m = 0; m < 4; ++m) { const int r = u.pm * BM + ai * HALF + wr * 64 + m * 16 + fr; const size_t off = (size_t)r * 1024 + col0; float ss = 0.f;
#pragma unroll
                for (int bj = 0; bj < 2; ++bj)
#pragma unroll
                    for (int n = 0; n < 2; ++n) { const f32x4 bs = *(const f32x4*)(base + off + bj * HALF + n * 16); const f32x4 o = bs + acc[ai][bj][m][n];
                        *(f32x4*)(out + off + bj * HALF + n * 16) = o;
                        if (WITH_BF16) { u32x2 w; w.x = cvt_pk_bf16(o[0], o[1]); w.y = cvt_pk_bf16(o[2], o[3]); *(u32x2*)(xb + off + bj * HALF + n * 16) = w;
                            ss += (o[0] * o[0] + o[1] * o[1]) + (o[2] * o[2] + o[3] * o[3]); } }
                if (WITH_BF16) { ss += __shfl_xor(ss, 16); ss += __shfl_xor(ss, 32); if (fq == 0) ssq[(size_t)r * 16 + u.pn * 4 + wc] = ss; } }
    }
};
struct EpiSwiGLU {
    static constexpr bool PERM = true, AFTER_DRAIN = false;
    bf16_t* O; int ldc; const float* ssq; float eps;
    __device__ __forceinline__ void operator()(const f32x4 (&acc)[2][2][4][2], const Unit& u, int wr, int wc, int fr, int fq) const {
        const int row0 = u.pm * BM + wr * 64 + fr, col0 = u.pn * HALF + wc * 32 + 8 * fq;
#pragma unroll
        for (int ai = 0; ai < 2; ++ai)
#pragma unroll
            for (int m = 0; m < 4; ++m) { const int r = row0 + ai * HALF + m * 16;
                const f32x4* sp = (const f32x4*)(ssq + (size_t)r * 16); const f32x4 s0 = sp[0], s1 = sp[1], s2 = sp[2], s3 = sp[3];
                const float tot = ((s0[0] + s0[1]) + (s0[2] + s0[3])) + ((s1[0] + s1[1]) + (s1[2] + s1[3])) + ((s2[0] + s2[1]) + (s2[2] + s2[3])) + ((s3[0] + s3[1]) + (s3[2] + s3[3]));
                const float rs = rsqrtf(tot * (1.0f / 1024.0f) + eps);
                float o[8];
#pragma unroll
                for (int n = 0; n < 2; ++n)
#pragma unroll
                    for (int i = 0; i < 4; ++i) { const float g = acc[ai][0][m][n][i] * rs, up = acc[ai][1][m][n][i] * rs;
                        const float sg = __builtin_amdgcn_rcpf(1.0f + __builtin_amdgcn_exp2f(-1.4426950408889634f * g)); o[4 * n + i] = g * sg * up; }
                u32x4 w; w.x = cvt_pk_bf16(o[0], o[1]); w.y = cvt_pk_bf16(o[2], o[3]); w.z = cvt_pk_bf16(o[4], o[5]); w.w = cvt_pk_bf16(o[6], o[7]);
                *(u32x4*)(O + (size_t)r * ldc + col0) = w; }
    }
};

template <class Epi, class Sched, bool ALIGN_EPI = false, bool SP2 = false>
__device__ __forceinline__ void gemm_phase(PG8_LAS unsigned char* lds, const Gemm g, const Sched& S, const Epi& E) {
    const int tid = threadIdx.x, wid = __builtin_amdgcn_readfirstlane(tid >> 6), lane = tid & 63, wr = wid >> 2, wc = wid & 3, fr = lane & 15, fq = lane >> 4;
    const int K = g.K, nt = K / BK;
    unsigned voffA[2], voffB[2];
#pragma unroll
    for (int i = 0; i < 2; ++i) { int R, C; stage_rc(tid * 16 + i * 8192, R, C); const int Rb = Epi::PERM ? ((R & ~31) + perm32(R & 31)) : R;
        voffA[i] = (unsigned)(R * K + C) * 2u; voffB[i] = (unsigned)(Rb * K + C) * 2u; }
    const size_t kstep = (size_t)(BK * 2);
    const size_t hstep = (size_t)HALF * K * 2;
    const size_t tstep = 2 * hstep;
    const unsigned ldsw = (unsigned)wid * 1024u;
    const int aoff = lds_byte(wr * 64 + fr, fq * 8), boff = lds_byte(wc * 32 + fr, fq * 8);
#define PG8_SA(b, h) (((b) * 2 + (h)) * HTB)
#define PG8_SB(b, h) ((4 + (b) * 2 + (h)) * HTB)
#define PG8_STAGE(bufoff, gbase, voff) do { _Pragma("unroll") for (int _i = 0; _i < 2; ++_i) \
        __builtin_amdgcn_global_load_lds((const unsigned*)((const char*)(gbase) + (voff)[_i]), (PG8_LAS unsigned*)(lds + (bufoff) + ldsw + _i * 8192), 16, 0, 0); } while (0)
#define PG8_LDA(dst, b, h) do { _Pragma("unroll") for (int m = 0; m < 4; ++m) _Pragma("unroll") for (int k = 0; k < 2; ++k) dst[m][k] = *(const PG8_LAS bf16x8*)(lds + PG8_SA(b, h) + aoff + m * 2048 + k * 1024); } while (0)
#define PG8_LDB(dst, b, h) do { _Pragma("unroll") for (int n = 0; n < 2; ++n) _Pragma("unroll") for (int k = 0; k < 2; ++k) dst[n][k] = *(const PG8_LAS bf16x8*)(lds + PG8_SB(b, h) + boff + n * 2048 + k * 1024); } while (0)
#define PG8_MMA(ai, bj, At, Bt) do { __builtin_amdgcn_s_setprio(1); _Pragma("unroll") for (int m = 0; m < 4; ++m) _Pragma("unroll") for (int n = 0; n < 2; ++n) _Pragma("unroll") for (int k = 0; k < 2; ++k) \
        acc[ai][bj][m][n] = __builtin_amdgcn_mfma_f32_16x16x32_bf16(Bt[n][k], At[m][k], acc[ai][bj][m][n], 0, 0, 0); __builtin_amdgcn_s_setprio(0); } while (0)
#define PG8_WAIT_V(n) asm volatile("s_waitcnt vmcnt(" #n ")" ::: "memory")
#define PG8_WAIT_L(n) asm volatile("s_waitcnt lgkmcnt(" #n ")" ::: "memory")
#define PG8_BAR __builtin_amdgcn_s_barrier()
#define PG8_SCHED __builtin_amdgcn_sched_barrier(0)
    Unit cur, nxt; int ui = 0;
    if (!S.next(0, cur)) return;
    f32x4 acc[2][2][4][2];
#pragma unroll
    for (int a = 0; a < 2; ++a)
#pragma unroll
        for (int b = 0; b < 2; ++b)
#pragma unroll
            for (int m = 0; m < 4; ++m)
#pragma unroll
                for (int n = 0; n < 2; ++n) acc[a][b][m][n] = (f32x4){0.f, 0.f, 0.f, 0.f};
    bf16x8 At[4][2], B0[2][2], B1[2][2];
    const char* cA = (const char*)g.A + (size_t)cur.pm * tstep; const char* cB = (const char*)g.Bt + (size_t)cur.pn * tstep;
    S.a_ready(cur);
    if constexpr (SP2) {
        PG8_STAGE(PG8_SB(0, 0), cB, voffB); PG8_STAGE(PG8_SB(0, 1), cB + hstep, voffB); PG8_STAGE(PG8_SA(0, 0), cA, voffA); PG8_STAGE(PG8_SA(0, 1), cA + hstep, voffA);
        if (wr == 1) PG8_BAR;
        PG8_WAIT_V(2); PG8_BAR;
        PG8_STAGE(PG8_SB(1, 0), cB + kstep, voffB); PG8_STAGE(PG8_SA(1, 0), cA + kstep, voffA); PG8_STAGE(PG8_SB(1, 1), cB + hstep + kstep, voffB);
        PG8_WAIT_V(6); PG8_BAR;
    } else {
        PG8_STAGE(PG8_SB(0, 0), cB, voffB); PG8_STAGE(PG8_SA(0, 0), cA, voffA); PG8_STAGE(PG8_SB(0, 1), cB + hstep, voffB); PG8_STAGE(PG8_SA(0, 1), cA + hstep, voffA);
        if (wr == 1) PG8_BAR;
        PG8_WAIT_V(4); PG8_BAR;
        PG8_STAGE(PG8_SB(1, 0), cB + kstep, voffB); PG8_STAGE(PG8_SA(1, 0), cA + kstep, voffA); PG8_STAGE(PG8_SB(1, 1), cB + hstep + kstep, voffB);
        PG8_WAIT_V(6); PG8_BAR;
    }
    for (;;) {
        const bool has_next = S.next(ui + 1, nxt);
        const char* nA = has_next ? (const char*)g.A + (size_t)nxt.pm * tstep : cA; const char* nB = has_next ? (const char*)g.Bt + (size_t)nxt.pn * tstep : cB;
        for (int t = 0; t < nt; t += 2) {
            const bool last = (t == nt - 2);
            const char* a1 = cA + (size_t)(t + 1) * kstep;
            const char* a2 = last ? nA : cA + (size_t)(t + 2) * kstep; const char* b2 = last ? nB : cB + (size_t)(t + 2) * kstep;
            const char* a3 = a2 + kstep; const char* b3 = b2 + kstep;
            if (last && has_next) S.a_ready(nxt);
            if constexpr (SP2) {
            PG8_LDB(B0, 0, 0); PG8_LDB(B1, 0, 1); PG8_SCHED; PG8_LDA(At, 0, 0); PG8_STAGE(PG8_SA(1, 1), a1 + hstep, voffA);
            PG8_WAIT_V(8); PG8_WAIT_L(0); PG8_BAR; PG8_MMA(0, 0, At, B0); PG8_MMA(0, 1, At, B1); PG8_BAR; PG8_SCHED;
            PG8_LDA(At, 0, 1); PG8_STAGE(PG8_SB(0, 0), b2, voffB); PG8_STAGE(PG8_SB(0, 1), b2 + hstep, voffB); PG8_STAGE(PG8_SA(0, 0), a2, voffA);
            PG8_WAIT_V(8); PG8_WAIT_L(0); PG8_BAR; PG8_MMA(1, 0, At, B0); PG8_MMA(1, 1, At, B1); PG8_BAR; PG8_SCHED;
            PG8_LDB(B0, 1, 0); PG8_LDB(B1, 1, 1); PG8_SCHED; PG8_LDA(At, 1, 0); PG8_STAGE(PG8_SA(0, 1), a2 + hstep, voffA);
            PG8_WAIT_V(8); PG8_WAIT_L(0); PG8_BAR; PG8_MMA(0, 0, At, B0); PG8_MMA(0, 1, At, B1); PG8_BAR; PG8_SCHED;
            PG8_LDA(At, 1, 1); PG8_STAGE(PG8_SB(1, 0), b3, voffB); PG8_STAGE(PG8_SB(1, 1), b3 + hstep, voffB); PG8_STAGE(PG8_SA(1, 0), a3, voffA);
            PG8_WAIT_V(8); PG8_WAIT_L(0); PG8_BAR; PG8_MMA(1, 0, At, B0); PG8_MMA(1, 1, At, B1); PG8_BAR; PG8_SCHED;
            } else {
            PG8_LDB(B0, 0, 0); PG8_SCHED; PG8_LDA(At, 0, 0); PG8_STAGE(PG8_SA(1, 1), a1 + hstep, voffA);
            PG8_WAIT_L(8); PG8_BAR; PG8_WAIT_L(0); PG8_MMA(0, 0, At, B0); PG8_BAR; PG8_SCHED;
            PG8_LDB(B1, 0, 1); PG8_STAGE(PG8_SB(0, 0), b2, voffB);
            PG8_BAR; PG8_WAIT_L(0); PG8_MMA(0, 1, At, B1); PG8_BAR;
            PG8_LDA(At, 0, 1); PG8_STAGE(PG8_SA(0, 0), a2, voffA);
            PG8_BAR; PG8_WAIT_L(0); PG8_MMA(1, 0, At, B0); PG8_BAR; PG8_SCHED;
            PG8_STAGE(PG8_SB(0, 1), b2 + hstep, voffB);
            PG8_WAIT_V(6); PG8_BAR; PG8_MMA(1, 1, At, B1); PG8_BAR;
            PG8_LDB(B0, 1, 0); PG8_SCHED; PG8_LDA(At, 1, 0); PG8_STAGE(PG8_SA(0, 1), a2 + hstep, voffA);
            PG8_WAIT_L(8); PG8_BAR; PG8_WAIT_L(0); PG8_MMA(0, 0, At, B0); PG8_BAR; PG8_SCHED;
            PG8_LDB(B1, 1, 1); PG8_STAGE(PG8_SB(1, 0), b3, voffB);
            PG8_BAR; PG8_WAIT_L(0); PG8_MMA(0, 1, At, B1); PG8_BAR;
            PG8_LDA(At, 1, 1); PG8_STAGE(PG8_SA(1, 0), a3, voffA);
            PG8_BAR; PG8_WAIT_L(0); PG8_MMA(1, 0, At, B0); PG8_BAR; PG8_SCHED;
            PG8_STAGE(PG8_SB(1, 1), b3 + hstep, voffB);
            PG8_WAIT_V(6); PG8_BAR; PG8_MMA(1, 1, At, B1); PG8_BAR;
            }
        }
        if constexpr (ALIGN_EPI) { if (wr == 0) PG8_BAR; }
        if constexpr (!Epi::AFTER_DRAIN) { E(acc, cur, wr, wc, fr, fq); S.done(cur); }
        if (!has_next) break;
#pragma unroll
        for (int a = 0; a < 2; ++a)
#pragma unroll
            for (int b = 0; b < 2; ++b)
#pragma unroll
                for (int m = 0; m < 4; ++m)
#pragma unroll
                    for (int n = 0; n < 2; ++n) acc[a][b][m][n] = (f32x4){0.f, 0.f, 0.f, 0.f};
        cur = nxt; cA = nA; cB = nB; ++ui;
        if constexpr (ALIGN_EPI) { if (wr == 1) PG8_BAR; }
    }
    PG8_WAIT_V(0);
    if constexpr (!ALIGN_EPI) { if (wr == 0) PG8_BAR; }
    PG8_BAR;
    if constexpr (Epi::AFTER_DRAIN) { E.fused(acc, cur, wr, wc, fr, fq, lds, wid, lane); S.done(cur); }
#undef PG8_SA
#undef PG8_SB
#undef PG8_STAGE
#undef PG8_LDA
#undef PG8_LDB
#undef PG8_MMA
#undef PG8_WAIT_V
#undef PG8_WAIT_L
#undef PG8_BAR
#undef PG8_SCHED
}
}
#ifndef MIXER_NAIVE
#define MIXER_NAIVE 0
#endif
#ifndef DIAG
#define DIAG 0
#endif
#ifndef SB_EARLY
#define SB_EARLY 0
#endif
#ifndef PG8_SP2
#define PG8_SP2 true
#endif
#ifndef PG8_ALIGN
#define PG8_ALIGN true
#endif
constexpr int NWAVES = 8;
constexpr int DM = 1024, NB = 16, SEQ = 2048, M = NB * SEQ, INC = 3584, DFF = 2816, NH = 8, HD = 64;
constexpr float EPS = 1e-6f;
constexpr float QSCALE = 0.125f * 1.4426950408889634f;
constexpr size_t MiB = 1u << 20;
constexpr size_t WS_CTL = 0, CTL_ZERO_BYTES = 64 * 1024;
constexpr size_t WS_WIN = 1 * MiB, WS_WOUT = 8 * MiB, WS_WGU = 10 * MiB, WS_WD = 21 * MiB;
constexpr size_t WS_SSQ2 = 27 * MiB;
constexpr size_t WS_XB = 32 * MiB;
constexpr size_t WS_PROJ = 96 * MiB, SEG_ELEMS = (size_t)M * 512;
constexpr size_t WS_FF = 96 * MiB;
constexpr size_t WS_MIX = 320 * MiB;
constexpr size_t WS_X1 = 384 * MiB, WS_END = 512 * MiB;
constexpr int CW_BAR = 4096;
constexpr int RING_OFF = 0, RING_BYTES = 131072;
constexpr int LDSCTL_OFF = RING_BYTES, MISC_OFF = LDSCTL_OFF + 320;
constexpr int LDS_BYTES = 147456;
#define GAS __attribute__((address_space(1)))
#define LAS __attribute__((address_space(3)))
typedef unsigned short bf16;
typedef unsigned v4u __attribute__((ext_vector_type(4)));
typedef float f32x4 __attribute__((ext_vector_type(4)));
typedef short bf16x8 __attribute__((ext_vector_type(8)));
typedef GAS unsigned gu32;
typedef GAS unsigned long long gu64;
#define RLX_AGENT __ATOMIC_RELAXED, __HIP_MEMORY_SCOPE_AGENT
#define LDS_WAIT() asm volatile("s_waitcnt lgkmcnt(0)" ::: "memory")
#define VM_WAIT() asm volatile("s_waitcnt vmcnt(0)" ::: "memory")
__device__ __forceinline__ unsigned long long rt() { return __builtin_amdgcn_s_memrealtime(); }
__device__ __forceinline__ unsigned f2bf(float f) { unsigned u = __builtin_bit_cast(unsigned, f); return (u + 0x7fffu + ((u >> 16) & 1u)) >> 16; }
__device__ __forceinline__ unsigned pk2(float lo, float hi) { return f2bf(lo) | (f2bf(hi) << 16); }

#define XB_TMO      128
#define XB_XCNT(j)  (256  + 64 * (j))
#define XB_XSUB(j)  (1280 + 64 * (j))
#define XB_XGEN(j)  (2304 + 64 * (j))
#define XB_TOP      3328
#define XB_TOPGEN   3392
#define XCD_BAR_WORDS 3456
#define XB_SPIN_CAP (1u << 18)

__device__ __forceinline__ unsigned xb_ld(unsigned* p)              { return __hip_atomic_load(p, __ATOMIC_RELAXED, __HIP_MEMORY_SCOPE_AGENT); }
__device__ __forceinline__ unsigned xb_add(unsigned* p, unsigned v) { return __hip_atomic_fetch_add(p, v, __ATOMIC_RELAXED, __HIP_MEMORY_SCOPE_AGENT); }
__device__ __forceinline__ unsigned xb_xcc_id() { return (unsigned)__builtin_amdgcn_s_getreg((3 << 11) | 20) & 0xFu; }
#define XB_SPIN(cond, bar) do { unsigned _sp = 0; while (cond) { __builtin_amdgcn_s_sleep(1); \
    if ((++_sp & 255u) == 0u) { if (xb_ld(&(bar)[XB_TMO])) break; if (_sp > XB_SPIN_CAP) { atomicAdd(&(bar)[XB_TMO], 1u); break; } } } } while (0)

struct XcdBarrier {
    unsigned* bar; unsigned x;
    volatile LAS unsigned* st;
};

__device__ __forceinline__ XcdBarrier xcd_barrier_post(unsigned* bar, volatile LAS unsigned* st) {
    XcdBarrier b; b.bar = bar; b.x = xb_xcc_id(); b.st = st;
    if (threadIdx.x == 0) (void)xb_add(&bar[XB_XCNT(b.x)], 1u);
    return b;
}
__device__ __forceinline__ void xcd_barrier_complete(unsigned* bar, unsigned x, unsigned& nloc, unsigned& nx) {
    const unsigned G = gridDim.x * gridDim.y * gridDim.z;
    unsigned sum, cnt, mine, sp = 0u;
    for (;;) {
        sum = 0u; cnt = 0u; mine = 0u;
#pragma unroll
        for (unsigned j = 0; j < 16; ++j) { const unsigned c = xb_ld(&bar[XB_XCNT(j)]); sum += c; cnt += (c > 0u) ? 1u : 0u; mine = (j == x) ? c : mine; }
        if (sum == G) break;
        __builtin_amdgcn_s_sleep(1);
        if ((++sp & 255u) == 0u) { if (xb_ld(&bar[XB_TMO])) break; if (sp > XB_SPIN_CAP) { atomicAdd(&bar[XB_TMO], 1u); break; } }
    }
    nloc = mine > 0u ? mine : 1u; nx = cnt > 0u ? cnt : 1u;
}

__device__ __forceinline__ void xcd_barrier(const XcdBarrier& b) {
    asm volatile("s_waitcnt vmcnt(0)" ::: "memory");
    __syncthreads();
    if (threadIdx.x == 0) {
        unsigned* bar = b.bar;
        __builtin_amdgcn_s_waitcnt(0);
        unsigned nloc = b.st[0], nx = b.st[1];
        if (nloc == 0u) { xcd_barrier_complete(bar, b.x, nloc, nx); b.st[0] = nloc; b.st[1] = nx; }
        const unsigned old = xb_add(&bar[XB_XSUB(b.x)], 1u);
        const unsigned gen = old / nloc;
        if (old + 1u == (gen + 1u) * nloc) {
            __builtin_amdgcn_fence(__ATOMIC_RELEASE, "agent");
            asm volatile("s_waitcnt vmcnt(0)" ::: "memory");
            const unsigned og = xb_add(&bar[XB_TOP], 1u);
            const unsigned tg = og / nx;
            if (og + 1u == (tg + 1u) * nx) xb_add(&bar[XB_TOPGEN], 1u);
            else XB_SPIN(xb_ld(&bar[XB_TOPGEN]) == tg, bar);
            __builtin_amdgcn_fence(__ATOMIC_ACQUIRE, "agent");
            xb_add(&bar[XB_XGEN(b.x)], 1u);
            asm volatile("s_waitcnt vmcnt(0)" ::: "memory");
        } else {
            XB_SPIN(xb_ld(&bar[XB_XGEN(b.x)]) == gen, bar);
            __builtin_amdgcn_fence(__ATOMIC_ACQUIRE, "agent");
            asm volatile("s_waitcnt vmcnt(0)" ::: "memory");
        }
    }
    __syncthreads();
}
struct Args { const float* in[12]; float* out; unsigned char* ws; };
__device__ __forceinline__ float wave_sum(float v) {
#pragma unroll
    for (int o = 1; o < 64; o <<= 1) v += __shfl_xor(v, o);
    return v;
}
__device__ __forceinline__ float bf2f(unsigned short b) { return __builtin_bit_cast(float, (unsigned)b << 16); }

__device__ __forceinline__ void p0_transpose_item(const float* W, int K, int N, bf16* WT, int drow0, const float* gk, LAS float* scr, int k0, int n0, int lane) {
#pragma unroll 8
    for (int i = 0; i < 32; ++i) { const int kk = 2 * i + (lane >> 5); float v = W[(size_t)(k0 + kk) * N + n0 + (lane & 31)]; if (gk) v *= gk[k0 + kk]; scr[kk * 33 + (lane & 31)] = v; }
    LDS_WAIT(); asm volatile("" ::: "memory");
    const int c = lane & 7;
#pragma unroll
    for (int j = 0; j < 4; ++j) { const int n = (lane >> 3) + 8 * j; const LAS float* s = scr + (8 * c) * 33 + n;
        v4u o; o.x = pk2(s[0 * 33], s[1 * 33]); o.y = pk2(s[2 * 33], s[3 * 33]); o.z = pk2(s[4 * 33], s[5 * 33]); o.w = pk2(s[6 * 33], s[7 * 33]);
        *(GAS v4u*)(WT + (size_t)(drow0 + n) * K + k0 + 8 * c) = o; }
    LDS_WAIT(); asm volatile("" ::: "memory");
}
__device__ __forceinline__ void rms_row_to_bf16(const float* xrow, bf16* orow, int lane) {
    const GAS f32x4* xr = (const GAS f32x4*)xrow + lane;
    f32x4 v[4]; float s = 0.f;
#pragma unroll
    for (int j = 0; j < 4; ++j) { v[j] = xr[64 * j]; s += (v[j].x * v[j].x + v[j].y * v[j].y) + (v[j].z * v[j].z + v[j].w * v[j].w); }
    const float rstd = rsqrtf(wave_sum(s) * (1.f / DM) + EPS);
    GAS unsigned long long* o8 = (GAS unsigned long long*)orow + lane;
#pragma unroll
    for (int j = 0; j < 4; ++j) o8[64 * j] = (unsigned long long)pk2(v[j].x * rstd, v[j].y * rstd) | ((unsigned long long)pk2(v[j].z * rstd, v[j].w * rstd) << 32);
}
__device__ __forceinline__ void rms_row_inplace(float* xrow, const float* g, int lane) {
    GAS f32x4* xr = (GAS f32x4*)xrow + lane;
    f32x4 v[4]; float s = 0.f;
#pragma unroll
    for (int j = 0; j < 4; ++j) { v[j] = xr[64 * j]; s += (v[j].x * v[j].x + v[j].y * v[j].y) + (v[j].z * v[j].z + v[j].w * v[j].w); }
    const float rstd = rsqrtf(wave_sum(s) * (1.f / DM) + EPS);
#pragma unroll
    for (int j = 0; j < 4; ++j) { const f32x4 gv = ((const GAS f32x4*)g)[lane + 64 * j]; xr[64 * j] = v[j] * rstd * gv; }
}
__device__ __forceinline__ float sigmoid_f(float x) { return 1.0f / (1.0f + __expf(-x)); }
__device__ __forceinline__ void hgrn_naive_task(int bh, const bf16* HQ, const bf16* HF, const bf16* HI, const bf16* HGt, const float* lbnd, const float* ng, bf16* mixed, LAS unsigned char* lds, int tid, const float* x, const float* mix_g, const float* w_in) {
    constexpr int TS = 8;
    LAS float* st = (LAS float*)lds;
    LAS float* part = st + 4 * TS * 64;
    const int b = bh >> 3, h = bh & 7, e = tid & 63, dg = tid >> 6;
    float lb[8], S[8];
#pragma unroll
    for (int i = 0; i < 8; ++i) { const int d = h * 64 + dg * 8 + i; const float l0 = lbnd[d], l1 = lbnd[512 + d]; lb[i] = 1.0f / (1.0f + __expf(l1 - l0)); S[i] = 0.f; }
    const float g = ng[h * 64 + e];
    LAS float* hp = part + TS * 8 * 64;
    { const float* xr = x + (size_t)(b * SEQ) * DM; const int lane = tid & 63;
      const float v0 = xr[tid], v1 = xr[tid + 512]; float s = wave_sum(v0 * v0 + v1 * v1);
      LAS float* red = hp + 128; if (lane == 0) red[dg] = s; __syncthreads();
      float tot = 0.f; for (int w = 0; w < 8; ++w) tot += red[w]; const float rstd = rsqrtf(tot * (1.0f / DM) + EPS);
      const int c = tid & 127, kp = tid >> 7; const int col = (c < 64) ? (h * 64 + c) : (512 + h * 64 + (c - 64));
      float acc = 0.f; for (int k = kp * 256; k < kp * 256 + 256; ++k) acc = fmaf(xr[k] * mix_g[k], w_in[(size_t)k * INC + col], acc);
      acc *= rstd; LAS float* pr = hp + 144; pr[kp * 128 + c] = acc; __syncthreads();
      if (tid < 128) hp[tid] = (pr[tid] + pr[128 + tid]) + (pr[256 + tid] + pr[384 + tid]);
      __syncthreads(); }
    for (int t0 = 0; t0 < SEQ; t0 += TS) {
        __syncthreads();
        { const size_t off = (size_t)(b * SEQ + t0 + dg) * 512 + h * 64 + e;
          st[(0 * TS + dg) * 64 + e] = bf2f(HQ[off]); st[(1 * TS + dg) * 64 + e] = bf2f(HF[off]); st[(2 * TS + dg) * 64 + e] = bf2f(HI[off]); st[(3 * TS + dg) * 64 + e] = bf2f(HGt[off]);
          if (t0 == 0 && dg == 0) { st[e] = hp[e]; st[(1 * TS) * 64 + e] = hp[64 + e]; } }
        __syncthreads();
#pragma unroll
        for (int s = 0; s < TS; ++s) { const float ve = st[(2 * TS + s) * 64 + e]; float po = 0.f;
#pragma unroll
            for (int i = 0; i < 8; ++i) { const float fl = st[(1 * TS + s) * 64 + dg * 8 + i], q = st[(0 * TS + s) * 64 + dg * 8 + i];
                const float f = lb[i] + (1.0f - lb[i]) * sigmoid_f(fl); S[i] = f * S[i] + (1.0f - f) * ve; po = fmaf(S[i], q, po); }
            part[(s * 8 + dg) * 64 + e] = po; }
        __syncthreads();
        { const int s = dg; float o = 0.f;
#pragma unroll
          for (int gq = 0; gq < 8; ++gq) o += part[(s * 8 + gq) * 64 + e];
          const float ms = wave_sum(o * o) * (1.0f / 64.0f); const float gt = st[(3 * TS + s) * 64 + e];
          const float y = o * rsqrtf(ms + EPS) * g * (gt * sigmoid_f(gt));
          mixed[(size_t)(b * SEQ + t0 + s) * DM + h * 64 + e] = (bf16)f2bf(y); }
    }
    __syncthreads();
}
__device__ __forceinline__ void sb_naive_task(int bh, int qb, const bf16* SQ, const bf16* SK, const bf16* SV, const float* ng, bf16* mixed, LAS unsigned char* wl, int lane) {
    LAS unsigned short* Ks = (LAS unsigned short*)wl;
    LAS unsigned short* Vs = Ks + 4096;
    const int b = bh >> 3, h = bh & 7, tq = qb * 64 + lane;
    float q[64], o[64];
    { const GAS v4u* qp = (const GAS v4u*)(SQ + (size_t)(b * SEQ + tq) * 512 + h * 64);
#pragma unroll
      for (int c = 0; c < 8; ++c) { const v4u w = qp[c];
#pragma unroll
          for (int i = 0; i < 4; ++i) { q[c * 8 + 2 * i] = __builtin_bit_cast(float, w[i] << 16); q[c * 8 + 2 * i + 1] = __builtin_bit_cast(float, w[i] & 0xffff0000u); } }
#pragma unroll
      for (int d = 0; d < 64; ++d) o[d] = 0.f; }
    float A = 0.f;
    for (int kt = qb; kt >= 0; --kt) {
        asm volatile("s_waitcnt lgkmcnt(0)" ::: "memory");
#pragma unroll
        for (int j = 0; j < 8; ++j) { const int c = lane + 64 * j, row = c >> 3, ch = c & 7; const size_t off = (size_t)(b * SEQ + kt * 64 + row) * 512 + h * 64 + ch * 8;
            *(LAS v4u*)(Ks + row * 64 + ch * 8) = *(const GAS v4u*)(SK + off); *(LAS v4u*)(Vs + row * 64 + ch * 8) = *(const GAS v4u*)(SV + off); }
        asm volatile("s_waitcnt lgkmcnt(0)" ::: "memory");
        for (int j = 63; j >= 0; --j) {
            const int s = kt * 64 + j; float z = 0.f;
#pragma unroll
            for (int c = 0; c < 8; ++c) { const v4u w = *(const LAS v4u*)(Ks + j * 64 + c * 8);
#pragma unroll
                for (int i = 0; i < 4; ++i) { z = fmaf(q[c * 8 + 2 * i], __builtin_bit_cast(float, w[i] << 16), z); z = fmaf(q[c * 8 + 2 * i + 1], __builtin_bit_cast(float, w[i] & 0xffff0000u), z); } }
            const bool act = s < tq;
            const float c2 = act ? (fmaxf(z, 0.f) + __builtin_amdgcn_logf(1.0f + __builtin_amdgcn_exp2f(-fabsf(z)))) : 0.f;
            const float w2 = act ? __builtin_amdgcn_exp2f(z - c2 - A) : 0.f;
            A += c2;
#pragma unroll
            for (int c = 0; c < 8; ++c) { const v4u w = *(const LAS v4u*)(Vs + j * 64 + c * 8);
#pragma unroll
                for (int i = 0; i < 4; ++i) { o[c * 8 + 2 * i] = fmaf(w2, __builtin_bit_cast(float, w[i] << 16), o[c * 8 + 2 * i]); o[c * 8 + 2 * i + 1] = fmaf(w2, __builtin_bit_cast(float, w[i] & 0xffff0000u), o[c * 8 + 2 * i + 1]); } }
        }
    }
    float ss = 0.f;
#pragma unroll
    for (int d = 0; d < 64; ++d) ss = fmaf(o[d], o[d], ss);
    const float r = rsqrtf(ss * (1.0f / 64.0f) + EPS);
    GAS v4u* op = (GAS v4u*)(mixed + (size_t)(b * SEQ + tq) * DM + 512 + h * 64);
#pragma unroll
    for (int c = 0; c < 8; ++c) { v4u w;
#pragma unroll
        for (int i = 0; i < 4; ++i) { const int d = c * 8 + 2 * i; w[i] = pk2(o[d] * r * ng[h * 64 + d], o[d + 1] * r * ng[h * 64 + d + 1]); }
        op[c] = w; }
}
namespace sbk {
typedef short bf16x8 __attribute__((ext_vector_type(8)));
typedef short s16x4 __attribute__((ext_vector_type(4)));
typedef float f32x16 __attribute__((ext_vector_type(16)));
typedef unsigned u32x4 __attribute__((ext_vector_type(4)));
typedef short v4i16_t __attribute__((ext_vector_type(4)));
constexpr int NSLOT = 3, SLOTB = 8192;
constexpr int LDS_K = 0, LDS_V = NSLOT * SLOTB, LDS_FLAG = 2 * NSLOT * SLOTB, LDS_OST = LDS_FLAG + 256, OSTW = 32 * 68 * 4, LDS_TOTAL = LDS_OST + 8 * OSTW;
__device__ __forceinline__ int crow(int r, int hi) { return (r & 3) + 8 * (r >> 2) + 4 * hi; }
__device__ __forceinline__ void glds16(const void* gsrc, unsigned lds_dst) { unsigned keep;
    asm volatile("s_mov_b32 %0, m0\n\ts_mov_b32 m0, %2\n\ts_nop 0\n\tglobal_load_lds_dwordx4 %1, off\n\ts_mov_b32 m0, %0" : "=&s"(keep) : "v"(gsrc), "s"(lds_dst) : "memory"); }
typedef float f32x2_t __attribute__((ext_vector_type(2))); typedef __bf16 bf16x2_t __attribute__((ext_vector_type(2)));
__device__ __forceinline__ unsigned cvtpk(float lo, float hi) { f32x2_t v = {lo, hi}; bf16x2_t b = __builtin_convertvector(v, bf16x2_t); return __builtin_bit_cast(unsigned, b); }
__device__ __forceinline__ s16x4 vtr(const LAS unsigned char* p) { return __builtin_bit_cast(s16x4, __builtin_amdgcn_ds_read_tr16_b64_v4i16((LAS v4i16_t*)p)); }
__device__ __forceinline__ float xchg32(float v, int hi) {
    auto rr = __builtin_amdgcn_permlane32_swap(__float_as_uint(v), __float_as_uint(v), false, false);
    return __uint_as_float(hi ? rr[0] : rr[1]); }
#define SB_WAIT_BAR(N) asm volatile("s_waitcnt vmcnt(" #N ") lgkmcnt(0)\n\ts_barrier" ::: "memory")

#define SB_QUAD(P, B, KV0, T) do { float r_[4], be_[4]; \
    _Pragma("unroll") for (int i_ = 0; i_ < 4; ++i_) { const float u_ = __builtin_amdgcn_exp2f(fminf(P[(B) + i_], 64.0f)); const float rr_ = __builtin_amdgcn_rcpf(1.0f + u_); float b_ = u_ * rr_; float r1_ = rr_; \
        if (BAND) { const bool m_ = ((KV0) + i_) >= qrel; r1_ = m_ ? 1.0f : r1_; b_ = m_ ? 0.0f : b_; } r_[i_] = r1_; be_[i_] = b_; } \
    const float s2_ = r_[3], s1_ = s2_ * r_[2], s0_ = s1_ * r_[1]; T = s0_ * r_[0]; \
    P[(B) + 3] = be_[3]; P[(B) + 2] = be_[2] * s2_; P[(B) + 1] = be_[1] * s1_; P[(B)] = be_[0] * s0_; } while (0)

template <bool BAND> __device__ __forceinline__ void sb_tile(f32x16& o0, f32x16& o1, float& Pacc, const bf16x8 (&qr)[4], const LAS unsigned char* Ks, const LAS unsigned char* Vs, int jb, int qrel, int lane) {
    const int r32 = lane & 31, hi = lane >> 5;
    f32x16 p0, p1;
    { const LAS unsigned char* kb = Ks + hi * 1024 + r32 * 16; const f32x16 z = {};
#pragma unroll
      for (int d0 = 0; d0 < 4; ++d0) { const bf16x8 b0 = *(const LAS bf16x8*)(kb + d0 * 2048); const bf16x8 b1 = *(const LAS bf16x8*)(kb + d0 * 2048 + 512);
          p0 = __builtin_amdgcn_mfma_f32_32x32x16_bf16(b0, qr[d0], d0 == 0 ? z : p0, 0, 0, 0); p1 = __builtin_amdgcn_mfma_f32_32x32x16_bf16(b1, qr[d0], d0 == 0 ? z : p1, 0, 0, 0); } }
    float T[8]; const int kvb = 64 * jb + 4 * hi;
    SB_QUAD(p1, 12, kvb + 32 + 24, T[0]); SB_QUAD(p1, 8, kvb + 32 + 16, T[1]); SB_QUAD(p1, 4, kvb + 32 + 8, T[2]); SB_QUAD(p1, 0, kvb + 32, T[3]);
    SB_QUAD(p0, 12, kvb + 24, T[4]); SB_QUAD(p0, 8, kvb + 16, T[5]); SB_QUAD(p0, 4, kvb + 8, T[6]); SB_QUAD(p0, 0, kvb, T[7]);
    float OE[8], OI[8]; OE[0] = 1.0f;
#pragma unroll
    for (int i = 0; i < 8; ++i) { OI[i] = OE[i] * T[i]; if (i < 7) OE[i + 1] = OI[i]; }
    float Off[8];
#pragma unroll
    for (int i = 0; i < 8; ++i) { const float X = xchg32(hi ? OI[i] : OE[i], hi); Off[i] = Pacc * OE[i] * X; if (i == 7) { const float cand = Pacc * OI[7] * X; const float pc = xchg32(cand, hi); Pacc = hi ? pc : cand; } }
#pragma unroll
    for (int i = 0; i < 4; ++i) { p1[12 + i] *= Off[0]; p1[8 + i] *= Off[1]; p1[4 + i] *= Off[2]; p1[i] *= Off[3]; p0[12 + i] *= Off[4]; p0[8 + i] *= Off[5]; p0[4 + i] *= Off[6]; p0[i] *= Off[7]; }
    u32x4 pw0, pw1, pw2, pw3;
#pragma unroll
    for (int i = 0; i < 4; ++i) { pw0[i] = cvtpk(p0[2 * i], p0[2 * i + 1]); pw1[i] = cvtpk(p0[8 + 2 * i], p0[8 + 2 * i + 1]); pw2[i] = cvtpk(p1[2 * i], p1[2 * i + 1]); pw3[i] = cvtpk(p1[8 + 2 * i], p1[8 + 2 * i + 1]); }
    const LAS unsigned char* vp = Vs + ((lane >> 4) & 1) * 32 + (lane & 3) * 8 + (4 * hi + ((lane & 15) >> 2)) * 64;
#define SB_VFR(i) ({ const s16x4 lo_ = vtr(vp + ((i) >> 2) * 4096 + ((i) & 3) * 1024), hi_ = vtr(vp + ((i) >> 2) * 4096 + ((i) & 3) * 1024 + 512); (bf16x8){lo_[0], lo_[1], lo_[2], lo_[3], hi_[0], hi_[1], hi_[2], hi_[3]}; })
    o0 = __builtin_amdgcn_mfma_f32_32x32x16_bf16(__builtin_bit_cast(bf16x8, pw0), SB_VFR(0), o0, 0, 0, 0); o1 = __builtin_amdgcn_mfma_f32_32x32x16_bf16(__builtin_bit_cast(bf16x8, pw0), SB_VFR(4), o1, 0, 0, 0);
    o0 = __builtin_amdgcn_mfma_f32_32x32x16_bf16(__builtin_bit_cast(bf16x8, pw1), SB_VFR(1), o0, 0, 0, 0); o1 = __builtin_amdgcn_mfma_f32_32x32x16_bf16(__builtin_bit_cast(bf16x8, pw1), SB_VFR(5), o1, 0, 0, 0);
    o0 = __builtin_amdgcn_mfma_f32_32x32x16_bf16(__builtin_bit_cast(bf16x8, pw2), SB_VFR(2), o0, 0, 0, 0); o1 = __builtin_amdgcn_mfma_f32_32x32x16_bf16(__builtin_bit_cast(bf16x8, pw2), SB_VFR(6), o1, 0, 0, 0);
    o0 = __builtin_amdgcn_mfma_f32_32x32x16_bf16(__builtin_bit_cast(bf16x8, pw3), SB_VFR(3), o0, 0, 0, 0); o1 = __builtin_amdgcn_mfma_f32_32x32x16_bf16(__builtin_bit_cast(bf16x8, pw3), SB_VFR(7), o1, 0, 0, 0);
#undef SB_VFR
}

template <bool EARLY> __device__ __forceinline__ void sb_unit(int bh, int qb, const bf16* SQ, const bf16* SK, const bf16* SV, const float* ng, bf16* MIXo, LAS unsigned char* shm) {
    const int tid = threadIdx.x, lane = tid & 63, r32 = lane & 31, hi = lane >> 5; const int wid = __builtin_amdgcn_readfirstlane(tid >> 6);
    const int b = bh >> 3, h = bh & 7; const long rowbase = (long)b * SEQ; const int q0 = qb * 256;
    const unsigned lds0 = (unsigned)(size_t)shm;
    const bf16* ksrc = SK + (rowbase + lane) * 512 + h * 64 + wid * 8;
    const bf16* vsrc = SV + (rowbase + 16 * (wid & 3) + (lane >> 2)) * 512 + h * 64 + (wid >> 2) * 32 + (lane & 3) * 8;
    const unsigned kdst = lds0 + LDS_K + wid * 1024, vdst = lds0 + LDS_V + wid * 1024;
#define SB_DMA(t, slot) do { glds16(ksrc + (long)(t) * 64 * 512, (unsigned)__builtin_amdgcn_readfirstlane(kdst + (slot))); glds16(vsrc + (long)(t) * 64 * 512, (unsigned)__builtin_amdgcn_readfirstlane(vdst + (slot))); } while (0)
    const int NT = 4 * qb + 4, t_top = 4 * qb + (wid >> 1), qrel = wid * 32 + r32;
    SB_DMA(NT - 1, 0);
    bf16x8 qr[4];
    { const bf16* Qw = SQ + (rowbase + q0 + wid * 32 + r32) * 512 + h * 64 + hi * 8;
#pragma unroll
      for (int d0 = 0; d0 < 4; ++d0) qr[d0] = *(const GAS bf16x8*)(Qw + d0 * 16); }
    f32x16 o0 = {}, o1 = {}; float Pacc = 1.0f;
    volatile LAS unsigned* flag = (volatile LAS unsigned*)(shm + LDS_FLAG);
    int sl_cur = 0, sl_next = SLOTB;
    for (int it = 0; it < NT; ++it) {
        const int t = NT - 1 - it;
        if (t > 0) { SB_DMA(t - 1, sl_next); SB_WAIT_BAR(2); } else { SB_WAIT_BAR(0); }
        if (EARLY && it > 0) { unsigned any = 0u;
#pragma unroll
            for (int w = 0; w < 8; ++w) any |= flag[((it - 1) & 1) * 8 + w];
            if (any == 0u) break; }
        if (t <= t_top) {
            const LAS unsigned char* Ks = shm + LDS_K + sl_cur; const LAS unsigned char* Vs = shm + LDS_V + sl_cur;
            if (t >= 4 * qb) sb_tile<true>(o0, o1, Pacc, qr, Ks, Vs, t - 4 * qb, qrel, lane);
            else sb_tile<false>(o0, o1, Pacc, qr, Ks, Vs, 0, qrel, lane);
        }
        if (EARLY) { const bool alive = __any(Pacc != 0.0f) != 0; if (lane == 0) flag[(it & 1) * 8 + wid] = alive ? 1u : 0u; }
        sl_cur = sl_next; sl_next = (sl_next == (NSLOT - 1) * SLOTB) ? 0 : sl_next + SLOTB;
    }
    { LAS float* stg = (LAS float*)(shm + LDS_OST + wid * OSTW);
#pragma unroll
      for (int r = 0; r < 16; ++r) { const int orow = crow(r, hi); stg[orow * 68 + r32] = o0[r]; stg[orow * 68 + 32 + r32] = o1[r]; }
      asm volatile("s_waitcnt lgkmcnt(0)" ::: "memory");
      const int row = lane >> 1, half = lane & 1; f32x4 v[8]; float ss = 0.f;
#pragma unroll
      for (int i = 0; i < 8; ++i) { v[i] = *(const LAS f32x4*)(stg + row * 68 + half * 32 + 4 * i); ss += (v[i].x * v[i].x + v[i].y * v[i].y) + (v[i].z * v[i].z + v[i].w * v[i].w); }
      ss += __shfl_xor(ss, 1);
      const float rs = rsqrtf(ss * (1.0f / 64.0f) + EPS);
      const float* gp = ng + h * 64 + half * 32; bf16* op = MIXo + (rowbase + q0 + wid * 32 + row) * DM + 512 + h * 64 + half * 32;
#pragma unroll
      for (int i = 0; i < 4; ++i) { const f32x4 g0 = *(const GAS f32x4*)(gp + 8 * i), g1 = *(const GAS f32x4*)(gp + 8 * i + 4); const f32x4 a = v[2 * i] * rs * g0, c = v[2 * i + 1] * rs * g1;
          u32x4 w; w.x = cvtpk(a.x, a.y); w.y = cvtpk(a.z, a.w); w.z = cvtpk(c.x, c.y); w.w = cvtpk(c.z, c.w); *(GAS u32x4*)(op + 8 * i) = w; } }
    asm volatile("s_waitcnt vmcnt(0) lgkmcnt(0)\n\ts_barrier" ::: "memory");
#undef SB_DMA
}
#undef SB_QUAD
#undef SB_WAIT_BAR
}
namespace hg {
typedef short bf16x8 __attribute__((ext_vector_type(8)));
typedef short s16x4 __attribute__((ext_vector_type(4)));
typedef unsigned u32x4 __attribute__((ext_vector_type(4)));
typedef unsigned u32x2 __attribute__((ext_vector_type(2)));
typedef short v4i16_t __attribute__((ext_vector_type(4)));
constexpr int IMG_QE = 0, IMG_KE = 8192, IMG_V = 16384, IMG_P = 24576, O_ST = 32768, DEC = O_ST + 64 * 68 * 4, HP = DEC + 256, LDS_TOTAL = HP + 4096;
__device__ __forceinline__ int img_off(int row, int col) { return row * 128 + ((((col >> 3) ^ row) & 7) << 4) + (col & 7) * 2; }
__device__ __forceinline__ s16x4 vtr(const LAS unsigned char* p) { return __builtin_bit_cast(s16x4, __builtin_amdgcn_ds_read_tr16_b64_v4i16((LAS v4i16_t*)p)); }
__device__ __forceinline__ unsigned cvtpk(float lo, float hi) { typedef float f2 __attribute__((ext_vector_type(2))); typedef __bf16 b2 __attribute__((ext_vector_type(2))); f2 v = {lo, hi}; b2 b = __builtin_convertvector(v, b2); return __builtin_bit_cast(unsigned, b); }
__device__ __forceinline__ float blo(unsigned w) { return __builtin_bit_cast(float, w << 16); }
__device__ __forceinline__ float bhi(unsigned w) { return __builtin_bit_cast(float, w & 0xffff0000u); }

__device__ __forceinline__ void hgrn_task(int bh, const bf16* HQ, const bf16* HF, const bf16* HI, const bf16* HGt, const float* lbnd, const float* ng, bf16* MIXo, LAS unsigned char* shm,
                                          const float* x, const float* mix_g, const float* w_in) {
    const int tid = threadIdx.x, lane = tid & 63; const int w = __builtin_amdgcn_readfirstlane(tid >> 6);
    const int b = bh >> 3, h = bh & 7; const long rowbase = (long)b * SEQ;
    const int c16 = lane & 15, g4 = lane >> 4, tq = (lane & 15) >> 2, tp = lane & 3;
    LAS float* ost = (LAS float*)(shm + O_ST); LAS float* decs = (LAS float*)(shm + DEC); LAS float* hp = (LAS float*)(shm + HP);
    for (int u = tid; u < 8192 / 16; u += 512) *(LAS u32x4*)(shm + IMG_P + u * 16) = (u32x4){0u, 0u, 0u, 0u};
    float lb[8];
#pragma unroll
    for (int i = 0; i < 8; ++i) { const int d = h * 64 + 8 * w + i; const float l0 = lbnd[d], l1 = lbnd[512 + d]; lb[i] = 1.0f / (1.0f + __expf(l1 - l0)); }
    { const float* xr = x + (size_t)rowbase * DM;
      const float v0 = xr[tid], v1 = xr[tid + 512]; const float s = wave_sum(v0 * v0 + v1 * v1);
      LAS float* red = hp + 128; if (lane == 0) red[w] = s; __syncthreads();
      float tot = 0.f; for (int i = 0; i < 8; ++i) tot += red[i]; const float rstd = rsqrtf(tot * (1.0f / DM) + EPS);
      const int c = tid & 127, kp = tid >> 7; const int col = (c < 64) ? (h * 64 + c) : (512 + h * 64 + (c - 64));
      float acc = 0.f; for (int k = kp * 256; k < kp * 256 + 256; ++k) acc = fmaf(xr[k] * mix_g[k], w_in[(size_t)k * INC + col], acc);
      acc *= rstd; LAS float* pr = hp + 144; pr[kp * 128 + c] = acc; __syncthreads();
      if (tid < 128) hp[tid] = (pr[tid] + pr[128 + tid]) + (pr[256 + tid] + pr[384 + tid]);
      __syncthreads();
      if (w == 0) { const int d = h * 64 + lane; const float l0 = lbnd[d], l1 = lbnd[512 + d]; const float lbd = 1.0f / (1.0f + __expf(l1 - l0));
          const float f0 = lbd + (1.0f - lbd) / (1.0f + __expf(-hp[64 + lane])); const float al = wave_sum((1.0f - f0) * hp[lane]); if (lane == 0) hp[136] = al; }
    }
    f32x4 S[4];
#pragma unroll
    for (int i = 0; i < 4; ++i) S[i] = (f32x4){0.f, 0.f, 0.f, 0.f};
    const size_t ld_off = (size_t)(rowbase + lane) * 512 + h * 64 + 8 * w;
    u32x4 nfl = *(const GAS u32x4*)(HF + ld_off), nq = *(const GAS u32x4*)(HQ + ld_off), nv = *(const GAS u32x4*)(HI + ld_off);
    const int erow = 8 * w + (lane >> 3), ec = (lane & 7) * 8;
    const size_t g_off = (size_t)(rowbase + erow) * 512 + h * 64 + ec;
    u32x4 ngate = *(const GAS u32x4*)(HGt + g_off);
    f32x4 gn0 = *(const GAS f32x4*)(ng + h * 64 + ec), gn1 = *(const GAS f32x4*)(ng + h * 64 + ec + 4);
    __syncthreads();
    for (int n = 0; n < SEQ / 64; ++n) {
        { float E[8], kk[8], qv[8];
#pragma unroll
          for (int i = 0; i < 4; ++i) { const float fa = blo(nfl[i]), fb = bhi(nfl[i]);
              const float f0 = lb[2 * i] + (1.0f - lb[2 * i]) * __builtin_amdgcn_rcpf(1.0f + __builtin_amdgcn_exp2f(-1.4426950408889634f * fa));
              const float f1 = lb[2 * i + 1] + (1.0f - lb[2 * i + 1]) * __builtin_amdgcn_rcpf(1.0f + __builtin_amdgcn_exp2f(-1.4426950408889634f * fb));
              E[2 * i] = f0; E[2 * i + 1] = f1; kk[2 * i] = 1.0f - f0; kk[2 * i + 1] = 1.0f - f1; qv[2 * i] = blo(nq[i]); qv[2 * i + 1] = bhi(nq[i]); }
#pragma unroll
          for (int off = 1; off < 64; off <<= 1) {
#pragma unroll
              for (int i = 0; i < 8; ++i) { const float t_ = __shfl_up(E[i], off); if (lane >= off) E[i] *= t_; } }
          if (lane == 63) { *(LAS f32x4*)(decs + 8 * w) = (f32x4){E[0], E[1], E[2], E[3]}; *(LAS f32x4*)(decs + 8 * w + 4) = (f32x4){E[4], E[5], E[6], E[7]}; }
          u32x4 qe, ke;
#pragma unroll
          for (int i = 0; i < 4; ++i) { const float i0 = __builtin_amdgcn_rcpf(E[2 * i]), i1 = __builtin_amdgcn_rcpf(E[2 * i + 1]);
              qe[i] = cvtpk(qv[2 * i] * E[2 * i], qv[2 * i + 1] * E[2 * i + 1]); ke[i] = cvtpk(kk[2 * i] * i0, kk[2 * i + 1] * i1); }
          const int io = img_off(lane, 8 * w);
          *(LAS u32x4*)(shm + IMG_QE + io) = qe; *(LAS u32x4*)(shm + IMG_KE + io) = ke; *(LAS u32x4*)(shm + IMG_V + io) = nv; }
        const u32x4 gate = ngate;
        if (n + 1 < SEQ / 64) { const size_t o2 = ld_off + (size_t)(n + 1) * 64 * 512; nfl = *(const GAS u32x4*)(HF + o2); nq = *(const GAS u32x4*)(HQ + o2); nv = *(const GAS u32x4*)(HI + o2);
            ngate = *(const GAS u32x4*)(HGt + g_off + (size_t)(n + 1) * 64 * 512); }
        __syncthreads();
#pragma unroll
        for (int rep = 0; rep < 2; ++rep) { const int idx = w + 8 * rep;
            if (idx < 10) { const int ib = idx < 1 ? 0 : idx < 3 ? 1 : idx < 6 ? 2 : 3; const int jb = idx - (ib * (ib + 1)) / 2;
                f32x4 acc = {0.f, 0.f, 0.f, 0.f};
#pragma unroll
                for (int ks = 0; ks < 2; ++ks) { const bf16x8 a = *(const LAS bf16x8*)(shm + IMG_KE + img_off(16 * jb + c16, 32 * ks + 8 * g4)); const bf16x8 bb = *(const LAS bf16x8*)(shm + IMG_QE + img_off(16 * ib + c16, 32 * ks + 8 * g4));
                    acc = __builtin_amdgcn_mfma_f32_16x16x32_bf16(a, bb, acc, 0, 0, 0); }
                if (jb == ib) {
#pragma unroll
                    for (int r = 0; r < 4; ++r) if (4 * g4 + r > c16) acc[r] = 0.f; }
                u32x2 pk; pk.x = cvtpk(acc[0], acc[1]); pk.y = cvtpk(acc[2], acc[3]);
                *(LAS u32x2*)(shm + IMG_P + img_off(16 * ib + c16, 16 * jb + 4 * g4)) = pk; } }
        __syncthreads();
        if (w < 4) {
            bf16x8 vf[2];
#pragma unroll
            for (int ks = 0; ks < 2; ++ks) { const s16x4 lo = vtr(shm + IMG_V + img_off(32 * ks + 8 * g4 + tq, 16 * w + 4 * tp)), hi = vtr(shm + IMG_V + img_off(32 * ks + 8 * g4 + 4 + tq, 16 * w + 4 * tp));
                vf[ks] = (bf16x8){lo[0], lo[1], lo[2], lo[3], hi[0], hi[1], hi[2], hi[3]}; }
            bf16x8 sf[2];
#pragma unroll
            for (int ks = 0; ks < 2; ++ks) { u32x4 t_; t_.x = cvtpk(S[2 * ks][0], S[2 * ks][1]); t_.y = cvtpk(S[2 * ks][2], S[2 * ks][3]); t_.z = cvtpk(S[2 * ks + 1][0], S[2 * ks + 1][1]); t_.w = cvtpk(S[2 * ks + 1][2], S[2 * ks + 1][3]); sf[ks] = __builtin_bit_cast(bf16x8, t_); }
#pragma unroll
            for (int ib = 0; ib < 4; ++ib) { f32x4 oa = {0.f, 0.f, 0.f, 0.f};
#pragma unroll
                for (int ks = 0; ks < 2; ++ks) { if (ks == 1 && ib < 2) continue;
                    const bf16x8 pa = *(const LAS bf16x8*)(shm + IMG_P + img_off(16 * ib + c16, 32 * ks + 8 * g4)); oa = __builtin_amdgcn_mfma_f32_16x16x32_bf16(pa, vf[ks], oa, 0, 0, 0); }
#pragma unroll
                for (int ks = 0; ks < 2; ++ks) { const u32x2 a0 = *(const LAS u32x2*)(shm + IMG_QE + img_off(16 * ib + c16, 32 * ks + 4 * g4)), a1 = *(const LAS u32x2*)(shm + IMG_QE + img_off(16 * ib + c16, 32 * ks + 16 + 4 * g4));
                    const u32x4 aa = {a0.x, a0.y, a1.x, a1.y}; oa = __builtin_amdgcn_mfma_f32_16x16x32_bf16(__builtin_bit_cast(bf16x8, aa), sf[ks], oa, 0, 0, 0); }
#pragma unroll
                for (int r = 0; r < 4; ++r) ost[(16 * ib + 4 * g4 + r) * 68 + 16 * w + c16] = oa[r]; }
#pragma unroll
            for (int blk = 0; blk < 4; ++blk) {
#pragma unroll
                for (int ks = 0; ks < 2; ++ks) { const s16x4 lo = vtr(shm + IMG_KE + img_off(32 * ks + 8 * g4 + tq, 16 * blk + 4 * tp)), hi = vtr(shm + IMG_KE + img_off(32 * ks + 8 * g4 + 4 + tq, 16 * blk + 4 * tp));
                    const bf16x8 ka = (bf16x8){lo[0], lo[1], lo[2], lo[3], hi[0], hi[1], hi[2], hi[3]}; S[blk] = __builtin_amdgcn_mfma_f32_16x16x32_bf16(ka, vf[ks], S[blk], 0, 0, 0); }
                const f32x4 dv = *(const LAS f32x4*)(decs + 16 * blk + 4 * g4); S[blk] = S[blk] * dv; }
        }
        __syncthreads();
        { f32x4 o0 = *(const LAS f32x4*)(ost + erow * 68 + ec), o1 = *(const LAS f32x4*)(ost + erow * 68 + ec + 4);
          if (n == 0 && erow == 0) { const float al = hp[136]; const u32x4 v0 = *(const LAS u32x4*)(shm + IMG_V + img_off(0, ec));
              o0 = (f32x4){blo(v0.x), bhi(v0.x), blo(v0.y), bhi(v0.y)} * al; o1 = (f32x4){blo(v0.z), bhi(v0.z), blo(v0.w), bhi(v0.w)} * al; }
          float ss = (o0.x * o0.x + o0.y * o0.y) + (o0.z * o0.z + o0.w * o0.w) + (o1.x * o1.x + o1.y * o1.y) + (o1.z * o1.z + o1.w * o1.w);
          ss += __shfl_xor(ss, 1); ss += __shfl_xor(ss, 2); ss += __shfl_xor(ss, 4);
          const float rs = rsqrtf(ss * (1.0f / 64.0f) + EPS);
          float gt[8];
#pragma unroll
          for (int i = 0; i < 4; ++i) { const float a = blo(gate[i]), c = bhi(gate[i]); gt[2 * i] = a * __builtin_amdgcn_rcpf(1.0f + __builtin_amdgcn_exp2f(-1.4426950408889634f * a)); gt[2 * i + 1] = c * __builtin_amdgcn_rcpf(1.0f + __builtin_amdgcn_exp2f(-1.4426950408889634f * c)); }
          const f32x4 y0 = o0 * rs * gn0 * (f32x4){gt[0], gt[1], gt[2], gt[3]}, y1 = o1 * rs * gn1 * (f32x4){gt[4], gt[5], gt[6], gt[7]};
          u32x4 wv; wv.x = cvtpk(y0.x, y0.y); wv.y = cvtpk(y0.z, y0.w); wv.z = cvtpk(y1.x, y1.y); wv.w = cvtpk(y1.z, y1.w);
          *(GAS u32x4*)(MIXo + (size_t)(rowbase + 64 * n + erow) * DM + h * 64 + ec) = wv; }
        if (n == 0) __syncthreads();
    }
    __syncthreads();
}
}
__global__ void __launch_bounds__(NWAVES * 64, 2) mega_fwd(Args args) {
    extern __shared__ __attribute__((aligned(16))) unsigned char lds_raw[];
    LAS unsigned char* lds = (LAS unsigned char*)lds_raw;
    volatile LAS unsigned* MISC = (volatile LAS unsigned*)(lds + MISC_OFF);
    const int tid = threadIdx.x, lane = tid & 63, wave = __builtin_amdgcn_readfirstlane(tid >> 6);
    const int G = gridDim.x; const int bx = blockIdx.x; const int vcu = (G % 8 == 0) ? (bx % 8) * (G / 8) + bx / 8 : bx;
    unsigned char* ws = args.ws;
    gu32* ctl = (gu32*)(ws + WS_CTL);
    const float* x = args.in[0]; const float* mix_g = args.in[1]; const float* w_in = args.in[2]; const float* lbnd = args.in[3]; const float* hgrn_g = args.in[4]; const float* sb_g = args.in[5];
    const float* w_out = args.in[6]; const float* ffn_g = args.in[7]; const float* w_gate = args.in[8]; const float* w_up = args.in[9]; const float* w_down = args.in[10]; const float* fin_g = args.in[11];
    float* out = args.out;
    bf16* Win_t = (bf16*)(ws + WS_WIN); bf16* Wout_t = (bf16*)(ws + WS_WOUT); bf16* Wgu_t = (bf16*)(ws + WS_WGU); bf16* Wd_t = (bf16*)(ws + WS_WD);
    float* SSQ2 = (float*)(ws + WS_SSQ2); bf16* XB = (bf16*)(ws + WS_XB); bf16* PROJ = (bf16*)(ws + WS_PROJ); bf16* FF = (bf16*)(ws + WS_FF); bf16* MIX = (bf16*)(ws + WS_MIX); float* X1 = (float*)(ws + WS_X1);
    for (int u = tid; u < (LDS_BYTES - LDSCTL_OFF) / 4; u += NWAVES * 64) ((LAS unsigned*)(lds + LDSCTL_OFF))[u] = 0u;
    __syncthreads();
    XcdBarrier bar = xcd_barrier_post((unsigned*)(ctl + CW_BAR), MISC + 8);
    const int gw = vcu * NWAVES + wave, NGW = G * NWAVES;

    {
        LAS float* scr = (LAS float*)(lds + RING_OFF + wave * 16384);
        constexpr int I_IN = (DM / 64) * (INC / 32), I_OUT = (DM / 64) * (DM / 32), I_G = (DM / 64) * (DFF / 32), I_D = (DFF / 64) * (DM / 32);
        constexpr int NITEMS = I_IN + I_OUT + 2 * I_G + I_D;
        for (int it = gw; it < NITEMS; it += NGW) {
            int r = it;
            if (r < I_IN) { const int nblk = INC / 32, k0 = 64 * (r / nblk), n0 = 32 * (r % nblk); p0_transpose_item(w_in, DM, INC, Win_t, n0, mix_g, scr, k0, n0, lane); continue; } r -= I_IN;
            if (r < I_OUT) { const int nblk = DM / 32, k0 = 64 * (r / nblk), n0 = 32 * (r % nblk); p0_transpose_item(w_out, DM, DM, Wout_t, n0, nullptr, scr, k0, n0, lane); continue; } r -= I_OUT;
            if (r < I_G) { const int nblk = DFF / 32, k0 = 64 * (r / nblk), n0 = 32 * (r % nblk); p0_transpose_item(w_gate, DM, DFF, Wgu_t, 256 * (n0 >> 7) + (n0 & 127), ffn_g, scr, k0, n0, lane); continue; } r -= I_G;
            if (r < I_G) { const int nblk = DFF / 32, k0 = 64 * (r / nblk), n0 = 32 * (r % nblk); p0_transpose_item(w_up, DM, DFF, Wgu_t, 256 * (n0 >> 7) + 128 + (n0 & 127), ffn_g, scr, k0, n0, lane); continue; } r -= I_G;
            { const int nblk = DM / 32, k0 = 64 * (r / nblk), n0 = 32 * (r % nblk); p0_transpose_item(w_down, DFF, DM, Wd_t, n0, nullptr, scr, k0, n0, lane); }
        }
        for (int m = gw; m < M; m += NGW) rms_row_to_bf16(x + (size_t)m * DM, XB + (size_t)m * DM, lane);
    }
    xcd_barrier(bar);
    { pg8::Gemm g{XB, Win_t, M, INC, DM}; pg8::StaticOrder S; S.init(M, INC, G, bx);
      pg8::EpiSplit E{PROJ, SEG_ELEMS, 4, QSCALE};
      pg8::gemm_phase<pg8::EpiSplit, pg8::StaticOrder, PG8_ALIGN, PG8_SP2>(lds + RING_OFF, g, S, E); }
    xcd_barrier(bar);
    {
        const bf16* HQ = PROJ; const bf16* HF = PROJ + SEG_ELEMS; const bf16* HI = PROJ + 2 * SEG_ELEMS; const bf16* HGt = PROJ + 3 * SEG_ELEMS;
        const bf16* SQ = PROJ + 4 * SEG_ELEMS; const bf16* SK = PROJ + 5 * SEG_ELEMS; const bf16* SV = PROJ + 6 * SEG_ELEMS;
#if MIXER_NAIVE || DIAG
        for (int bh = vcu; bh < NB * NH; bh += G) hgrn_naive_task(bh, HQ, HF, HI, HGt, lbnd, hgrn_g, MIX, lds + RING_OFF, tid, x, mix_g, w_in);
        for (int p = gw; p < NB * NH * 16; p += NGW) { const int bh = p >> 4, s = p & 15;
            sb_naive_task(bh, s, SQ, SK, SV, sb_g, MIX, lds + RING_OFF + wave * 16384, lane);
            sb_naive_task(bh, 31 - s, SQ, SK, SV, sb_g, MIX, lds + RING_OFF + wave * 16384, lane); }
        __syncthreads();
#endif
#if !MIXER_NAIVE
        bf16* MIXN = DIAG ? (bf16*)out : MIX;
        static_assert(sbk::LDS_TOTAL <= RING_BYTES && hg::LDS_TOTAL <= RING_BYTES, "mixer LDS");
        for (int bh = vcu; bh < NB * NH; bh += G) hg::hgrn_task(bh, HQ, HF, HI, HGt, lbnd, hgrn_g, MIXN, lds + RING_OFF, x, mix_g, w_in);
        for (int p = vcu; p < NB * NH * 4; p += G) { const int bh = p >> 2, s = p & 3;
            sbk::sb_unit<SB_EARLY != 0>(bh, 7 - s, SQ, SK, SV, sb_g, MIXN, lds + RING_OFF);
            sbk::sb_unit<SB_EARLY != 0>(bh, s, SQ, SK, SV, sb_g, MIXN, lds + RING_OFF); }
#endif
    }
    xcd_barrier(bar);
#if DIAG
    { const bf16* A = MIX; const bf16* Bq = (const bf16*)out; float sd = 0.f, sa = 0.f; const int c0 = (DIAG == 1) ? 0 : 512;
      for (size_t i = (size_t)bx * 512 + tid; i < (size_t)M * 512; i += (size_t)G * 512) { const size_t r = i >> 9, c = c0 + (i & 511); const float a = bf2f(A[r * DM + c]); float d = a - bf2f(Bq[r * DM + c]); if (!(d == d)) d = 1e3f; sd += d * d; sa += a * a; }
      sd = wave_sum(sd); sa = wave_sum(sa);
      if (lane == 0) { atomicAdd((float*)(ctl + 8), sd); atomicAdd((float*)(ctl + 9), sa); } }
    xcd_barrier(bar);
#endif
    { pg8::Gemm g{MIX, Wout_t, M, DM, DM}; pg8::StaticOrder S; S.init(M, DM, G, bx);
      pg8::EpiRes<true> E{x, X1, XB, SSQ2};
      pg8::gemm_phase<pg8::EpiRes<true>, pg8::StaticOrder, PG8_ALIGN, PG8_SP2>(lds + RING_OFF, g, S, E); }
    xcd_barrier(bar);
    { pg8::Gemm g{XB, Wgu_t, M, 2 * DFF, DM}; pg8::StaticOrder S; S.init(M, 2 * DFF, G, bx);
      pg8::EpiSwiGLU E{FF, DFF, SSQ2, EPS};
      pg8::gemm_phase<pg8::EpiSwiGLU, pg8::StaticOrder, PG8_ALIGN, PG8_SP2>(lds + RING_OFF, g, S, E); }
    xcd_barrier(bar);
    { pg8::Gemm g{FF, Wd_t, M, DM, DFF}; pg8::StaticOrder S; S.init(M, DM, G, bx);
      pg8::EpiRes<false> E{X1, out, nullptr, nullptr};
      pg8::gemm_phase<pg8::EpiRes<false>, pg8::StaticOrder, PG8_ALIGN, PG8_SP2>(lds + RING_OFF, g, S, E); }
    xcd_barrier(bar);
    for (int m = gw; m < M; m += NGW) rms_row_inplace(out + (size_t)m * DM, fin_g, lane);
#if DIAG
    xcd_barrier(bar);
    if (bx == 0) { const float dm = 20.0f * sqrtf(__uint_as_float(__hip_atomic_load(ctl + 8, RLX_AGENT)) / __uint_as_float(__hip_atomic_load(ctl + 9, RLX_AGENT))); for (int i = tid; i < 4096; i += 512) out[i] += dm; }
#endif
}

extern "C" void kernel_launch(void* const* d_in, const int* in_sizes, int n_in, void* d_out, int out_size, void* d_ws, size_t ws_size, hipStream_t stream) {
    static int grid = 0;
    if (grid == 0) {
        if (n_in != 12 || in_sizes[0] != M * DM || out_size != M * DM || ws_size < WS_END) { fprintf(stderr, "kernel_launch: unexpected shapes (n_in %d, in0 %d, out %d, ws %zu)\n", n_in, n_in > 0 ? in_sizes[0] : -1, out_size, ws_size); grid = -1; return; }
        int dev = 0, cus = 0;
        if (hipGetDevice(&dev) != hipSuccess || hipDeviceGetAttribute(&cus, hipDeviceAttributeMultiprocessorCount, dev) != hipSuccess) { grid = -1; return; }
        if (hipFuncSetAttribute((const void*)mega_fwd, hipFuncAttributeMaxDynamicSharedMemorySize, LDS_BYTES) != hipSuccess) { fprintf(stderr, "kernel_launch: hipFuncSetAttribute failed\n"); grid = -1; return; }
        (void)hipGetLastError();
        grid = cus;
    }
    if (grid < 0) return;
    (void)hipMemsetAsync((char*)d_ws + WS_CTL, 0, CTL_ZERO_BYTES, stream);
    Args a{};
    for (int i = 0; i < 12; ++i) a.in[i] = (const float*)d_in[i];
    a.out = (float*)d_out; a.ws = (unsigned char*)d_ws;
    hipLaunchKernelGGL(mega_fwd, dim3(grid), dim3(NWAVES * 64), LDS_BYTES, stream, a);
}
```

```cpp
#define SB_EARLY 1
#include <hip/hip_runtime.h>
#include <cstdio>
#include <cstdint>
namespace pg8 {
#define PG8_LAS __attribute__((address_space(3)))
typedef unsigned short bf16_t;
typedef short bf16x8 __attribute__((ext_vector_type(8)));
typedef float f32x4 __attribute__((ext_vector_type(4)));
typedef unsigned u32x4 __attribute__((ext_vector_type(4)));
constexpr int BM = 256, BK = 64, HALF = 128, HTB = HALF * BK * 2  , STAGE_BYTES = 8 * HTB, NXCD = 8, WGM = 8;

__host__ __device__ __forceinline__ int lds_byte(int r, int c) { const int st = (r >> 4) * 2 + (c >> 5), rr = r & 15, cc = c & 31, ob = rr * 64 + cc * 2; return st * 1024 + (ob ^ (((ob >> 9) & 1) << 5)); }
__host__ __device__ __forceinline__ void stage_rc(int b, int& R, int& C) { const int st = b / 1024, sb = b % 1024, swz = sb ^ (((sb >> 9) & 1) << 5); R = (st >> 1) * 16 + swz / 64; C = (st & 1) * 32 + (swz % 64) / 2; }
__host__ __device__ __forceinline__ int perm32(int rho) { const int n = rho >> 4, i = rho & 15; return 8 * (i >> 2) + 4 * n + (i & 3); }

struct Unit { int pm, pn; };
struct Gemm { const bf16_t* A; const bf16_t* Bt; int M, N, K; };

struct StaticOrder {
    int nM, nN, nwg, G, c;
    __host__ __device__ void init(int M, int N, int G_, int c_) { nM = M / BM; nN = N / BM; nwg = nM * nN; G = G_; c = c_; }
    __host__ __device__ bool next(int i, Unit& u) const {
        const long L = (long)i * G + c; if (L >= nwg) return false;
        int wgid = (int)L; { const int q = nwg / NXCD, r = nwg % NXCD, xcd = wgid % NXCD, off = wgid / NXCD; wgid = (xcd < r ? xcd * (q + 1) : r * (q + 1) + (xcd - r) * q) + off; }
        const int nig = WGM * nN, gid = wgid / nig, fm = gid * WGM, gsz = (nM - fm) < WGM ? (nM - fm) : WGM;
        u.pm = fm + ((wgid % nig) % gsz); u.pn = (wgid % nig) / gsz; return true;
    }
    __device__ __forceinline__ void a_ready(const Unit&) const {}
    __device__ __forceinline__ void done(const Unit&) const {}
};

__device__ __forceinline__ unsigned cvt_pk_bf16(float lo, float hi) { unsigned r; asm volatile("v_cvt_pk_bf16_f32 %0, %1, %2" : "=v"(r) : "v"(lo), "v"(hi)); return r; }
typedef unsigned u32x2 __attribute__((ext_vector_type(2)));

struct EpiSplit {
    static constexpr bool PERM = true, AFTER_DRAIN = false;
    bf16_t* O; size_t split_stride; int qseg; float qscale;
    __device__ __forceinline__ void operator()(const f32x4 (&acc)[2][2][4][2], const Unit& u, int wr, int wc, int fr, int fq) const {
        const int row0 = u.pm * BM + wr * 64 + fr; int colt = u.pn * BM;
        const int t = colt >> 9; bf16_t* base = O + (size_t)t * split_stride; colt -= t << 9;
        const float sc = (t == qseg) ? qscale : 1.0f;
        const int col0 = colt + wc * 32 + 8 * fq;
#pragma unroll
        for (int ai = 0; ai < 2; ++ai)
#pragma unroll
            for (int m = 0; m < 4; ++m) { bf16_t* rowp = base + (size_t)(row0 + ai * HALF + m * 16) * 512 + col0;
#pragma unroll
                for (int bj = 0; bj < 2; ++bj) { f32x4 v0 = acc[ai][bj][m][0] * sc, v1 = acc[ai][bj][m][1] * sc;
                    u32x4 w; w.x = cvt_pk_bf16(v0[0], v0[1]); w.y = cvt_pk_bf16(v0[2], v0[3]); w.z = cvt_pk_bf16(v1[0], v1[1]); w.w = cvt_pk_bf16(v1[2], v1[3]);
                    *(u32x4*)(rowp + bj * HALF) = w; } }
    }
};
template <bool WITH_BF16> struct EpiRes {
    static constexpr bool PERM = false, AFTER_DRAIN = false;
    const float* base; float* out; bf16_t* xb; float* ssq;
    __device__ __forceinline__ void operator()(const f32x4 (&acc)[2][2][4][2], const Unit& u, int wr, int wc, int fr, int fq) const {
        const int col0 = u.pn * BM + wc * 32 + 4 * fq;
#pragma unroll
        for (int ai = 0; ai < 2; ++ai)
#pragma unroll
            for (int m = 0; m < 4; ++m) { const int r = u.pm * BM + ai * HALF + wr * 64 + m * 16 + fr; const size_t off = (size_t)r * 1024 + col0; float ss = 0.f;
#pragma unroll
                for (int bj = 0; bj < 2; ++bj)
#pragma unroll
                    for (int n = 0; n < 2; ++n) { const f32x4 bs = *(const f32x4*)(base + off + bj * HALF + n * 16); const f32x4 o = bs + acc[ai][bj][m][n];
                        *(f32x4*)(out + off + bj * HALF + n * 16) = o;
                        if (WITH_BF16) { u32x2 w; w.x = cvt_pk_bf16(o[0], o[1]); w.y = cvt_pk_bf16(o[2], o[3]); *(u32x2*)(xb + off + bj * HALF + n * 16) = w;
                            ss += (o[0] * o[0] + o[1] * o[1]) + (o[2] * o[2] + o[3] * o[3]); } }
                if (WITH_BF16) { ss += __shfl_xor(ss, 16); ss += __shfl_xor(ss, 32); if (fq == 0) ssq[(size_t)r * 16 + u.pn * 4 + wc] = ss; } }
    }
};
struct EpiSwiGLU {
    static constexpr bool PERM = true, AFTER_DRAIN = false;
    bf16_t* O; int ldc; const float* ssq; float eps;
    __device__ __forceinline__ void operator()(const f32x4 (&acc)[2][2][4][2], const Unit& u, int wr, int wc, int fr, int fq) const {
        const int row0 = u.pm * BM + wr * 64 + fr, col0 = u.pn * HALF + wc * 32 + 8 * fq;
#pragma unroll
        for (int ai = 0; ai < 2; ++ai)
#pragma unroll
            for (int m = 0; m < 4; ++m) { const int r = row0 + ai * HALF + m * 16;
                const f32x4* sp = (const f32x4*)(ssq + (size_t)r * 16); const f32x4 s0 = sp[0], s1 = sp[1], s2 = sp[2], s3 = sp[3];
                const float tot = ((s0[0] + s0[1]) + (s0[2] + s0[3])) + ((s1[0] + s1[1]) + (s1[2] + s1[3])) + ((s2[0] + s2[1]) + (s2[2] + s2[3])) + ((s3[0] + s3[1]) + (s3[2] + s3[3]));
                const float rs = rsqrtf(tot * (1.0f / 1024.0f) + eps);
                float o[8];
#pragma unroll
                for (int n = 0; n < 2; ++n)
#pragma unroll
                    for (int i = 0; i < 4; ++i) { const float g = acc[ai][0][m][n][i] * rs, up = acc[ai][1][m][n][i] * rs;
                        const float sg = __builtin_amdgcn_rcpf(1.0f + __builtin_amdgcn_exp2f(-1.4426950408889634f * g)); o[4 * n + i] = g * sg * up; }
                u32x4 w; w.x = cvt_pk_bf16(o[0], o[1]); w.y = cvt_pk_bf16(o[2], o[3]); w.z = cvt_pk_bf16(o[4], o[5]); w.w = cvt_pk_bf16(o[6], o[7]);
                *(u32x4*)(O + (size_t)r * ldc + col0) = w; }
    }
};

template <class Epi, class Sched, bool ALIGN_EPI = false, bool SP2 = false>
__device__ __forceinline__ void gemm_phase(PG8_LAS unsigned char* lds, const Gemm g, const Sched& S, const Epi& E) {
    const int tid = threadIdx.x, wid = __builtin_amdgcn_readfirstlane(tid >> 6), lane = tid & 63, wr = wid >> 2, wc = wid & 3, fr = lane & 15, fq = lane >> 4;
    const int K = g.K, nt = K / BK;
    unsigned voffA[2], voffB[2];
#pragma unroll
    for (int i = 0; i < 2; ++i) { int R, C; stage_rc(tid * 16 + i * 8192, R, C); const int Rb = Epi::PERM ? ((R & ~31) + perm32(R & 31)) : R;
        voffA[i] = (unsigned)(R * K + C) * 2u; voffB[i] = (unsigned)(Rb * K + C) * 2u; }
    const size_t kstep = (size_t)(BK * 2);
    const size_t hstep = (size_t)HALF * K * 2;
    const size_t tstep = 2 * hstep;
    const unsigned ldsw = (unsigned)wid * 1024u;
    const int aoff = lds_byte(wr * 64 + fr, fq * 8), boff = lds_byte(wc * 32 + fr, fq * 8);
#define PG8_SA(b, h) (((b) * 2 + (h)) * HTB)
#define PG8_SB(b, h) ((4 + (b) * 2 + (h)) * HTB)
#define PG8_STAGE(bufoff, gbase, voff) do { _Pragma("unroll") for (int _i = 0; _i < 2; ++_i) \
        __builtin_amdgcn_global_load_lds((const unsigned*)((const char*)(gbase) + (voff)[_i]), (PG8_LAS unsigned*)(lds + (bufoff) + ldsw + _i * 8192), 16, 0, 0); } while (0)
#define PG8_LDA(dst, b, h) do { _Pragma("unroll") for (int m = 0; m < 4; ++m) _Pragma("unroll") for (int k = 0; k < 2; ++k) dst[m][k] = *(const PG8_LAS bf16x8*)(lds + PG8_SA(b, h) + aoff + m * 2048 + k * 1024); } while (0)
#define PG8_LDB(dst, b, h) do { _Pragma("unroll") for (int n = 0; n < 2; ++n) _Pragma("unroll") for (int k = 0; k < 2; ++k) dst[n][k] = *(const PG8_LAS bf16x8*)(lds + PG8_SB(b, h) + boff + n * 2048 + k * 1024); } while (0)
#define PG8_MMA(ai, bj, At, Bt) do { __builtin_amdgcn_s_setprio(1); _Pragma("unroll") for (int m = 0; m < 4; ++m) _Pragma("unroll") for (int n = 0; n < 2; ++n) _Pragma("unroll") for (int k = 0; k < 2; ++k) \
        acc[ai][bj][m][n] = __builtin_amdgcn_mfma_f32_16x16x32_bf16(Bt[n][k], At[m][k], acc[ai][bj][m][n], 0, 0, 0); __builtin_amdgcn_s_setprio(0); } while (0)
#define PG8_WAIT_V(n) asm volatile("s_waitcnt vmcnt(" #n ")" ::: "memory")
#define PG8_WAIT_L(n) asm volatile("s_waitcnt lgkmcnt(" #n ")" ::: "memory")
#define PG8_BAR __builtin_amdgcn_s_barrier()
#define PG8_SCHED __builtin_amdgcn_sched_barrier(0)
    Unit cur, nxt; int ui = 0;
    if (!S.next(0, cur)) return;
    f32x4 acc[2][2][4][2];
#pragma unroll
    for (int a = 0; a < 2; ++a)
#pragma unroll
        for (int b = 0; b < 2; ++b)
#pragma unroll
            for (int m = 0; m < 4; ++m)
#pragma unroll
                for (int n = 0; n < 2; ++n) acc[a][b][m][n] = (f32x4){0.f, 0.f, 0.f, 0.f};
    bf16x8 At[4][2], B0[2][2], B1[2][2];
    const char* cA = (const char*)g.A + (size_t)cur.pm * tstep; const char* cB = (const char*)g.Bt + (size_t)cur.pn * tstep;
    S.a_ready(cur);
    if constexpr (SP2) {
        PG8_STAGE(PG8_SB(0, 0), cB, voffB); PG8_STAGE(PG8_SB(0, 1), cB + hstep, voffB); PG8_STAGE(PG8_SA(0, 0), cA, voffA); PG8_STAGE(PG8_SA(0, 1), cA + hstep, voffA);
        if (wr == 1) PG8_BAR;
        PG8_WAIT_V(2); PG8_BAR;
        PG8_STAGE(PG8_SB(1, 0), cB + kstep, voffB); PG8_STAGE(PG8_SA(1, 0), cA + kstep, voffA); PG8_STAGE(PG8_SB(1, 1), cB + hstep + kstep, voffB);
        PG8_WAIT_V(6); PG8_BAR;
    } else {
        PG8_STAGE(PG8_SB(0, 0), cB, voffB); PG8_STAGE(PG8_SA(0, 0), cA, voffA); PG8_STAGE(PG8_SB(0, 1), cB + hstep, voffB); PG8_STAGE(PG8_SA(0, 1), cA + hstep, voffA);
        if (wr == 1) PG8_BAR;
        PG8_WAIT_V(4); PG8_BAR;
        PG8_STAGE(PG8_SB(1, 0), cB + kstep, voffB); PG8_STAGE(PG8_SA(1, 0), cA + kstep, voffA); PG8_STAGE(PG8_SB(1, 1), cB + hstep + kstep, voffB);
        PG8_WAIT_V(6); PG8_BAR;
    }
    for (;;) {
        const bool has_next = S.next(ui + 1, nxt);
        const char* nA = has_next ? (const char*)g.A + (size_t)nxt.pm * tstep : cA; const char* nB = has_next ? (const char*)g.Bt + (size_t)nxt.pn * tstep : cB;
        for (int t = 0; t < nt; t += 2) {
            const bool last = (t == nt - 2);
            const char* a1 = cA + (size_t)(t + 1) * kstep;
            const char* a2 = last ? nA : cA + (size_t)(t + 2) * kstep; const char* b2 = last ? nB : cB + (size_t)(t + 2) * kstep;
            const char* a3 = a2 + kstep; const char* b3 = b2 + kstep;
            if (last && has_next) S.a_ready(nxt);
            if constexpr (SP2) {
            PG8_LDB(B0, 0, 0); PG8_LDB(B1, 0, 1); PG8_SCHED; PG8_LDA(At, 0, 0); PG8_STAGE(PG8_SA(1, 1), a1 + hstep, voffA);
            PG8_WAIT_V(8); PG8_WAIT_L(0); PG8_BAR; PG8_MMA(0, 0, At, B0); PG8_MMA(0, 1, At, B1); PG8_BAR; PG8_SCHED;
            PG8_LDA(At, 0, 1); PG8_STAGE(PG8_SB(0, 0), b2, voffB); PG8_STAGE(PG8_SB(0, 1), b2 + hstep, voffB); PG8_STAGE(PG8_SA(0, 0), a2, voffA);
            PG8_WAIT_V(8); PG8_WAIT_L(0); PG8_BAR; PG8_MMA(1, 0, At, B0); PG8_MMA(1, 1, At, B1); PG8_BAR; PG8_SCHED;
            PG8_LDB(B0, 1, 0); PG8_LDB(B1, 1, 1); PG8_SCHED; PG8_LDA(At, 1, 0); PG8_STAGE(PG8_SA(0, 1), a2 + hstep, voffA);
            PG8_WAIT_V(8); PG8_WAIT_L(0); PG8_BAR; PG8_MMA(0, 0, At, B0); PG8_MMA(0, 1, At, B1); PG8_BAR; PG8_SCHED;
            PG8_LDA(At, 1, 1); PG8_STAGE(PG8_SB(1, 0), b3, voffB); PG8_STAGE(PG8_SB(1, 1), b3 + hstep, voffB); PG8_STAGE(PG8_SA(1, 0), a3, voffA);
            PG8_WAIT_V(8); PG8_WAIT_L(0); PG8_BAR; PG8_MMA(1, 0, At, B0); PG8_MMA(1, 1, At, B1); PG8_BAR; PG8_SCHED;
            } else {
            PG8_LDB(B0, 0, 0); PG8_SCHED; PG8_LDA(At, 0, 0); PG8_STAGE(PG8_SA(1, 1), a1 + hstep, voffA);
            PG8_WAIT_L(8); PG8_BAR; PG8_WAIT_L(0); PG8_MMA(0, 0, At, B0); PG8_BAR; PG8_SCHED;
            PG8_LDB(B1, 0, 1); PG8_STAGE(PG8_SB(0, 0), b2, voffB);
            PG8_BAR; PG8_WAIT_L(0); PG8_MMA(0, 1, At, B1); PG8_BAR;
            PG8_LDA(At, 0, 1); PG8_STAGE(PG8_SA(0, 0), a2, voffA);
            PG8_BAR; PG8_WAIT_L(0); PG8_MMA(1, 0, At, B0); PG8_BAR; PG8_SCHED;
            PG8_STAGE(PG8_SB(0, 1), b2 + hstep, voffB);
            PG8_WAIT_V(6); PG8_BAR; PG8_MMA(1, 1, At, B1); PG8_BAR;
            PG8_LDB(B0, 1, 0); PG8_SCHED; PG8_LDA(At, 1, 0); PG8_STAGE(PG8_SA(0, 1), a2 + hstep, voffA);
            PG8_WAIT_L(8); PG8_BAR; PG8_WAIT_L(0); PG8_MMA(0, 0, At, B0); PG8_BAR; PG8_SCHED;
            PG8_LDB(B1, 1, 1); PG8_STAGE(PG8_SB(1, 0), b3, voffB);
            PG8_BAR; PG8_WAIT_L(0); PG8_MMA(0, 1, At, B1); PG8_BAR;
            PG8_LDA(At, 1, 1); PG8_STAGE(PG8_SA(1, 0), a3, voffA);
            PG8_BAR; PG8_WAIT_L(0); PG8_MMA(1, 0, At, B0); PG8_BAR; PG8_SCHED;
            PG8_STAGE(PG8_SB(1, 1), b3 + hstep, voffB);
            PG8_WAIT_V(6); PG8_BAR; PG8_MMA(1, 1, At, B1); PG8_BAR;
            }
        }
        if constexpr (ALIGN_EPI) { if (wr == 0) PG8_BAR; }
        if constexpr (!Epi::AFTER_DRAIN) { E(acc, cur, wr, wc, fr, fq); S.done(cur); }
        if (!has_next) break;
#pragma unroll
        for (int a = 0; a < 2; ++a)
#pragma unroll
            for (int b = 0; b < 2; ++b)
#pragma unroll
                for (int m = 0; m < 4; ++m)
#pragma unroll
                    for (int n = 0; n < 2; ++n) acc[a][b][m][n] = (f32x4){0.f, 0.f, 0.f, 0.f};
        cur = nxt; cA = nA; cB = nB; ++ui;
        if constexpr (ALIGN_EPI) { if (wr == 1) PG8_BAR; }
    }
    PG8_WAIT_V(0);
    if constexpr (!ALIGN_EPI) { if (wr == 0) PG8_BAR; }
    PG8_BAR;
    if constexpr (Epi::AFTER_DRAIN) { E.fused(acc, cur, wr, wc, fr, fq, lds, wid, lane); S.done(cur); }
#undef PG8_SA
#undef PG8_SB
#undef PG8_STAGE
#undef PG8_LDA
#undef PG8_LDB
#undef PG8_MMA
#undef PG8_WAIT_V
#undef PG8_WAIT_L
#undef PG8_BAR
#undef PG8_SCHED
}
}
#ifndef REP
#define REP 0
#endif
#ifndef MIXER_NAIVE
#define MIXER_NAIVE 0
#endif
#ifndef DIAG
#define DIAG 0
#endif
#ifndef SB_EARLY
#define SB_EARLY 0
#endif
#ifndef PG8_SP2
#define PG8_SP2 true
#endif
#ifndef PG8_ALIGN
#define PG8_ALIGN true
#endif
constexpr int NWAVES = 8;
constexpr int DM = 1024, NB = 16, SEQ = 2048, M = NB * SEQ, INC = 3584, DFF = 2816, NH = 8, HD = 64;
constexpr float EPS = 1e-6f;
constexpr float QSCALE = 0.125f * 1.4426950408889634f;
constexpr size_t MiB = 1u << 20;
constexpr size_t WS_CTL = 0, CTL_ZERO_BYTES = 64 * 1024;
constexpr size_t WS_WIN = 1 * MiB, WS_WOUT = 8 * MiB, WS_WGU = 10 * MiB, WS_WD = 21 * MiB;
constexpr size_t WS_SSQ2 = 27 * MiB;
constexpr size_t WS_T0 = 29 * MiB, WS_RSTD = 30 * MiB;
constexpr size_t WS_XB = 32 * MiB;
constexpr size_t WS_PROJ = 96 * MiB, SEG_ELEMS = (size_t)M * 512;
constexpr size_t WS_FF = 96 * MiB;
constexpr size_t WS_MIX = 320 * MiB;
constexpr size_t WS_X1 = 384 * MiB, WS_END = 512 * MiB;
constexpr int CW_BAR = 4096;
constexpr int RING_OFF = 0, RING_BYTES = 131072;
constexpr int LDSCTL_OFF = RING_BYTES, MISC_OFF = LDSCTL_OFF + 320;
constexpr int LDS_BYTES = 147456;
#define GAS __attribute__((address_space(1)))
#define LAS __attribute__((address_space(3)))
typedef unsigned short bf16;
typedef unsigned v4u __attribute__((ext_vector_type(4)));
typedef float f32x4 __attribute__((ext_vector_type(4)));
typedef short bf16x8 __attribute__((ext_vector_type(8)));
typedef GAS unsigned gu32;
typedef GAS unsigned long long gu64;
#define RLX_AGENT __ATOMIC_RELAXED, __HIP_MEMORY_SCOPE_AGENT
#define LDS_WAIT() asm volatile("s_waitcnt lgkmcnt(0)" ::: "memory")
#define VM_WAIT() asm volatile("s_waitcnt vmcnt(0)" ::: "memory")
__device__ __forceinline__ unsigned long long rt() { return __builtin_amdgcn_s_memrealtime(); }
__device__ __forceinline__ unsigned f2bf(float f) { unsigned u = __builtin_bit_cast(unsigned, f); return (u + 0x7fffu + ((u >> 16) & 1u)) >> 16; }
__device__ __forceinline__ unsigned pk2(float lo, float hi) { return f2bf(lo) | (f2bf(hi) << 16); }

#define XB_TMO      128
#define XB_XCNT(j)  (256  + 64 * (j))
#define XB_XSUB(j)  (1280 + 64 * (j))
#define XB_XGEN(j)  (2304 + 64 * (j))
#define XB_TOP      3328
#define XB_TOPGEN   3392
#define XCD_BAR_WORDS 3456
#define XB_SPIN_CAP (1u << 18)

__device__ __forceinline__ unsigned xb_ld(unsigned* p)              { return __hip_atomic_load(p, __ATOMIC_RELAXED, __HIP_MEMORY_SCOPE_AGENT); }
__device__ __forceinline__ unsigned xb_add(unsigned* p, unsigned v) { return __hip_atomic_fetch_add(p, v, __ATOMIC_RELAXED, __HIP_MEMORY_SCOPE_AGENT); }
__device__ __forceinline__ unsigned xb_xcc_id() { return (unsigned)__builtin_amdgcn_s_getreg((3 << 11) | 20) & 0xFu; }
#define XB_SPIN(cond, bar) do { unsigned _sp = 0; while (cond) { __builtin_amdgcn_s_sleep(1); \
    if ((++_sp & 255u) == 0u) { if (xb_ld(&(bar)[XB_TMO])) break; if (_sp > XB_SPIN_CAP) { atomicAdd(&(bar)[XB_TMO], 1u); break; } } } } while (0)

struct XcdBarrier {
    unsigned* bar; unsigned x;
    volatile LAS unsigned* st;
};

__device__ __forceinline__ XcdBarrier xcd_barrier_post(unsigned* bar, volatile LAS unsigned* st) {
    XcdBarrier b; b.bar = bar; b.x = xb_xcc_id(); b.st = st;
    if (threadIdx.x == 0) (void)xb_add(&bar[XB_XCNT(b.x)], 1u);
    return b;
}
__device__ __forceinline__ void xcd_barrier_complete(unsigned* bar, unsigned x, unsigned& nloc, unsigned& nx) {
    const unsigned G = gridDim.x * gridDim.y * gridDim.z;
    unsigned sum, cnt, mine, sp = 0u;
    for (;;) {
        sum = 0u; cnt = 0u; mine = 0u;
#pragma unroll
        for (unsigned j = 0; j < 16; ++j) { const unsigned c = xb_ld(&bar[XB_XCNT(j)]); sum += c; cnt += (c > 0u) ? 1u : 0u; mine = (j == x) ? c : mine; }
        if (sum == G) break;
        __builtin_amdgcn_s_sleep(1);
        if ((++sp & 255u) == 0u) { if (xb_ld(&bar[XB_TMO])) break; if (sp > XB_SPIN_CAP) { atomicAdd(&bar[XB_TMO], 1u); break; } }
    }
    nloc = mine > 0u ? mine : 1u; nx = cnt > 0u ? cnt : 1u;
}

__device__ __forceinline__ void xcd_barrier(const XcdBarrier& b) {
    asm volatile("s_waitcnt vmcnt(0)" ::: "memory");
    __syncthreads();
    if (threadIdx.x == 0) {
        unsigned* bar = b.bar;
        __builtin_amdgcn_s_waitcnt(0);
        unsigned nloc = b.st[0], nx = b.st[1];
        if (nloc == 0u) { xcd_barrier_complete(bar, b.x, nloc, nx); b.st[0] = nloc; b.st[1] = nx; }
        const unsigned old = xb_add(&bar[XB_XSUB(b.x)], 1u);
        const unsigned gen = old / nloc;
        if (old + 1u == (gen + 1u) * nloc) {
            __builtin_amdgcn_fence(__ATOMIC_RELEASE, "agent");
            asm volatile("s_waitcnt vmcnt(0)" ::: "memory");
            const unsigned og = xb_add(&bar[XB_TOP], 1u);
            const unsigned tg = og / nx;
            if (og + 1u == (tg + 1u) * nx) xb_add(&bar[XB_TOPGEN], 1u);
            else XB_SPIN(xb_ld(&bar[XB_TOPGEN]) == tg, bar);
            __builtin_amdgcn_fence(__ATOMIC_ACQUIRE, "agent");
            xb_add(&bar[XB_XGEN(b.x)], 1u);
            asm volatile("s_waitcnt vmcnt(0)" ::: "memory");
        } else {
            XB_SPIN(xb_ld(&bar[XB_XGEN(b.x)]) == gen, bar);
            __builtin_amdgcn_fence(__ATOMIC_ACQUIRE, "agent");
            asm volatile("s_waitcnt vmcnt(0)" ::: "memory");
        }
    }
    __syncthreads();
}
struct Args { const float* in[12]; float* out; unsigned char* ws; };
__device__ __forceinline__ float wave_sum(float v) {
#pragma unroll
    for (int o = 1; o < 64; o <<= 1) v += __shfl_xor(v, o);
    return v;
}
__device__ __forceinline__ float bf2f(unsigned short b) { return __builtin_bit_cast(float, (unsigned)b << 16); }

__device__ __forceinline__ void p0_transpose_item(const float* W, int K, int N, bf16* WT, int drow0, const float* gk, LAS float* scr, int k0, int n0, int lane) {
#pragma unroll 8
    for (int i = 0; i < 32; ++i) { const int kk = 2 * i + (lane >> 5); float v = W[(size_t)(k0 + kk) * N + n0 + (lane & 31)]; if (gk) v *= gk[k0 + kk]; scr[kk * 33 + (lane & 31)] = v; }
    LDS_WAIT(); asm volatile("" ::: "memory");
    const int c = lane & 7;
#pragma unroll
    for (int j = 0; j < 4; ++j) { const int n = (lane >> 3) + 8 * j; const LAS float* s = scr + (8 * c) * 33 + n;
        v4u o; o.x = pk2(s[0 * 33], s[1 * 33]); o.y = pk2(s[2 * 33], s[3 * 33]); o.z = pk2(s[4 * 33], s[5 * 33]); o.w = pk2(s[6 * 33], s[7 * 33]);
        *(GAS v4u*)(WT + (size_t)(drow0 + n) * K + k0 + 8 * c) = o; }
    LDS_WAIT(); asm volatile("" ::: "memory");
}
__device__ __forceinline__ void rms_row_to_bf16(const float* xrow, bf16* orow, float* rstd_out, int lane) {
    const GAS f32x4* xr = (const GAS f32x4*)xrow + lane;
    f32x4 v[4]; float s = 0.f;
#pragma unroll
    for (int j = 0; j < 4; ++j) { v[j] = xr[64 * j]; s += (v[j].x * v[j].x + v[j].y * v[j].y) + (v[j].z * v[j].z + v[j].w * v[j].w); }
    const float rstd = rsqrtf(wave_sum(s) * (1.f / DM) + EPS);
    if (lane == 0) *rstd_out = rstd;
    GAS unsigned long long* o8 = (GAS unsigned long long*)orow + lane;
#pragma unroll
    for (int j = 0; j < 4; ++j) o8[64 * j] = (unsigned long long)pk2(v[j].x * rstd, v[j].y * rstd) | ((unsigned long long)pk2(v[j].z * rstd, v[j].w * rstd) << 32);
}
__device__ __forceinline__ void rms_row_inplace(float* xrow, const float* g, int lane) {
    GAS f32x4* xr = (GAS f32x4*)xrow + lane;
    f32x4 v[4]; float s = 0.f;
#pragma unroll
    for (int j = 0; j < 4; ++j) { v[j] = xr[64 * j]; s += (v[j].x * v[j].x + v[j].y * v[j].y) + (v[j].z * v[j].z + v[j].w * v[j].w); }
    const float rstd = rsqrtf(wave_sum(s) * (1.f / DM) + EPS);
#pragma unroll
    for (int j = 0; j < 4; ++j) { const f32x4 gv = ((const GAS f32x4*)g)[lane + 64 * j]; xr[64 * j] = v[j] * rstd * gv; }
}

__device__ __forceinline__ void p0_token0_item(int item, const float* x, const float* mix_g, const float* w_in, float* T0, int lane) {
    const int cg = item & 15, b = (item >> 4) & 15, ks = item >> 8;
    const float* xr = x + (size_t)b * SEQ * DM + ks * 128; const float* gr = mix_g + ks * 128;
    const float xa = xr[lane] * gr[lane], xb2 = xr[64 + lane] * gr[64 + lane];
    const float* wp = w_in + (size_t)(ks * 128) * INC + cg * 64 + lane;
    float a0 = 0.f, a1 = 0.f, a2 = 0.f, a3 = 0.f;
#pragma unroll 4
    for (int kk = 0; kk < 64; kk += 4) {
        const float w0 = wp[(size_t)(kk + 0) * INC], w1 = wp[(size_t)(kk + 1) * INC], w2 = wp[(size_t)(kk + 2) * INC], w3 = wp[(size_t)(kk + 3) * INC];
        const float w4 = wp[(size_t)(64 + kk + 0) * INC], w5 = wp[(size_t)(64 + kk + 1) * INC], w6 = wp[(size_t)(64 + kk + 2) * INC], w7 = wp[(size_t)(64 + kk + 3) * INC];
        a0 = fmaf(__shfl(xa, kk + 0), w0, a0); a1 = fmaf(__shfl(xa, kk + 1), w1, a1); a2 = fmaf(__shfl(xa, kk + 2), w2, a2); a3 = fmaf(__shfl(xa, kk + 3), w3, a3);
        a0 = fmaf(__shfl(xb2, kk + 0), w4, a0); a1 = fmaf(__shfl(xb2, kk + 1), w5, a1); a2 = fmaf(__shfl(xb2, kk + 2), w6, a2); a3 = fmaf(__shfl(xb2, kk + 3), w7, a3);
    }
    T0[((size_t)ks * 16 + b) * 1024 + cg * 64 + lane] = (a0 + a1) + (a2 + a3);
}
__device__ __forceinline__ float sigmoid_f(float x) { return 1.0f / (1.0f + __expf(-x)); }
__device__ __forceinline__ void hgrn_naive_task(int bh, const bf16* HQ, const bf16* HF, const bf16* HI, const bf16* HGt, const float* lbnd, const float* ng, bf16* mixed, LAS unsigned char* lds, int tid, const float* x, const float* mix_g, const float* w_in) {
    constexpr int TS = 8;
    LAS float* st = (LAS float*)lds;
    LAS float* part = st + 4 * TS * 64;
    const int b = bh >> 3, h = bh & 7, e = tid & 63, dg = tid >> 6;
    float lb[8], S[8];
#pragma unroll
    for (int i = 0; i < 8; ++i) { const int d = h * 64 + dg * 8 + i; const float l0 = lbnd[d], l1 = lbnd[512 + d]; lb[i] = 1.0f / (1.0f + __expf(l1 - l0)); S[i] = 0.f; }
    const float g = ng[h * 64 + e];
    LAS float* hp = part + TS * 8 * 64;
    { const float* xr = x + (size_t)(b * SEQ) * DM; const int lane = tid & 63;
      const float v0 = xr[tid], v1 = xr[tid + 512]; float s = wave_sum(v0 * v0 + v1 * v1);
      LAS float* red = hp + 128; if (lane == 0) red[dg] = s; __syncthreads();
      float tot = 0.f; for (int w = 0; w < 8; ++w) tot += red[w]; const float rstd = rsqrtf(tot * (1.0f / DM) + EPS);
      const int c = tid & 127, kp = tid >> 7; const int col = (c < 64) ? (h * 64 + c) : (512 + h * 64 + (c - 64));
      float acc = 0.f; for (int k = kp * 256; k < kp * 256 + 256; ++k) acc = fmaf(xr[k] * mix_g[k], w_in[(size_t)k * INC + col], acc);
      acc *= rstd; LAS float* pr = hp + 144; pr[kp * 128 + c] = acc; __syncthreads();
      if (tid < 128) hp[tid] = (pr[tid] + pr[128 + tid]) + (pr[256 + tid] + pr[384 + tid]);
      __syncthreads(); }
    for (int t0 = 0; t0 < SEQ; t0 += TS) {
        __syncthreads();
        { const size_t off = (size_t)(b * SEQ + t0 + dg) * 512 + h * 64 + e;
          st[(0 * TS + dg) * 64 + e] = bf2f(HQ[off]); st[(1 * TS + dg) * 64 + e] = bf2f(HF[off]); st[(2 * TS + dg) * 64 + e] = bf2f(HI[off]); st[(3 * TS + dg) * 64 + e] = bf2f(HGt[off]);
          if (t0 == 0 && dg == 0) { st[e] = hp[e]; st[(1 * TS) * 64 + e] = hp[64 + e]; } }
        __syncthreads();
#pragma unroll
        for (int s = 0; s < TS; ++s) { const float ve = st[(2 * TS + s) * 64 + e]; float po = 0.f;
#pragma unroll
            for (int i = 0; i < 8; ++i) { const float fl = st[(1 * TS + s) * 64 + dg * 8 + i], q = st[(0 * TS + s) * 64 + dg * 8 + i];
                const float f = lb[i] + (1.0f - lb[i]) * sigmoid_f(fl); S[i] = f * S[i] + (1.0f - f) * ve; po = fmaf(S[i], q, po); }
            part[(s * 8 + dg) * 64 + e] = po; }
        __syncthreads();
        { const int s = dg; float o = 0.f;
#pragma unroll
          for (int gq = 0; gq < 8; ++gq) o += part[(s * 8 + gq) * 64 + e];
          const float ms = wave_sum(o * o) * (1.0f / 64.0f); const float gt = st[(3 * TS + s) * 64 + e];
          const float y = o * rsqrtf(ms + EPS) * g * (gt * sigmoid_f(gt));
          mixed[(size_t)(b * SEQ + t0 + s) * DM + h * 64 + e] = (bf16)f2bf(y); }
    }
    __syncthreads();
}
__device__ __forceinline__ void sb_naive_task(int bh, int qb, const bf16* SQ, const bf16* SK, const bf16* SV, const float* ng, bf16* mixed, LAS unsigned char* wl, int lane) {
    LAS unsigned short* Ks = (LAS unsigned short*)wl;
    LAS unsigned short* Vs = Ks + 4096;
    const int b = bh >> 3, h = bh & 7, tq = qb * 64 + lane;
    float q[64], o[64];
    { const GAS v4u* qp = (const GAS v4u*)(SQ + (size_t)(b * SEQ + tq) * 512 + h * 64);
#pragma unroll
      for (int c = 0; c < 8; ++c) { const v4u w = qp[c];
#pragma unroll
          for (int i = 0; i < 4; ++i) { q[c * 8 + 2 * i] = __builtin_bit_cast(float, w[i] << 16); q[c * 8 + 2 * i + 1] = __builtin_bit_cast(float, w[i] & 0xffff0000u); } }
#pragma unroll
      for (int d = 0; d < 64; ++d) o[d] = 0.f; }
    float A = 0.f;
    for (int kt = qb; kt >= 0; --kt) {
        asm volatile("s_waitcnt lgkmcnt(0)" ::: "memory");
#pragma unroll
        for (int j = 0; j < 8; ++j) { const int c = lane + 64 * j, row = c >> 3, ch = c & 7; const size_t off = (size_t)(b * SEQ + kt * 64 + row) * 512 + h * 64 + ch * 8;
            *(LAS v4u*)(Ks + row * 64 + ch * 8) = *(const GAS v4u*)(SK + off); *(LAS v4u*)(Vs + row * 64 + ch * 8) = *(const GAS v4u*)(SV + off); }
        asm volatile("s_waitcnt lgkmcnt(0)" ::: "memory");
        for (int j = 63; j >= 0; --j) {
            const int s = kt * 64 + j; float z = 0.f;
#pragma unroll
            for (int c = 0; c < 8; ++c) { const v4u w = *(const LAS v4u*)(Ks + j * 64 + c * 8);
#pragma unroll
                for (int i = 0; i < 4; ++i) { z = fmaf(q[c * 8 + 2 * i], __builtin_bit_cast(float, w[i] << 16), z); z = fmaf(q[c * 8 + 2 * i + 1], __builtin_bit_cast(float, w[i] & 0xffff0000u), z); } }
            const bool act = s < tq;
            const float c2 = act ? (fmaxf(z, 0.f) + __builtin_amdgcn_logf(1.0f + __builtin_amdgcn_exp2f(-fabsf(z)))) : 0.f;
            const float w2 = act ? __builtin_amdgcn_exp2f(z - c2 - A) : 0.f;
            A += c2;
#pragma unroll
            for (int c = 0; c < 8; ++c) { const v4u w = *(const LAS v4u*)(Vs + j * 64 + c * 8);
#pragma unroll
                for (int i = 0; i < 4; ++i) { o[c * 8 + 2 * i] = fmaf(w2, __builtin_bit_cast(float, w[i] << 16), o[c * 8 + 2 * i]); o[c * 8 + 2 * i + 1] = fmaf(w2, __builtin_bit_cast(float, w[i] & 0xffff0000u), o[c * 8 + 2 * i + 1]); } }
        }
    }
    float ss = 0.f;
#pragma unroll
    for (int d = 0; d < 64; ++d) ss = fmaf(o[d], o[d], ss);
    const float r = rsqrtf(ss * (1.0f / 64.0f) + EPS);
    GAS v4u* op = (GAS v4u*)(mixed + (size_t)(b * SEQ + tq) * DM + 512 + h * 64);
#pragma unroll
    for (int c = 0; c < 8; ++c) { v4u w;
#pragma unroll
        for (int i = 0; i < 4; ++i) { const int d = c * 8 + 2 * i; w[i] = pk2(o[d] * r * ng[h * 64 + d], o[d + 1] * r * ng[h * 64 + d + 1]); }
        op[c] = w; }
}
namespace sbk {
typedef short bf16x8 __attribute__((ext_vector_type(8)));
typedef short s16x4 __attribute__((ext_vector_type(4)));
typedef float f32x16 __attribute__((ext_vector_type(16)));
typedef unsigned u32x4 __attribute__((ext_vector_type(4)));
typedef short v4i16_t __attribute__((ext_vector_type(4)));
constexpr int NSLOT = 3, SLOTB = 8192;
constexpr int LDS_K = 0, LDS_V = NSLOT * SLOTB, LDS_FLAG = 2 * NSLOT * SLOTB, LDS_OST = LDS_FLAG + 256, OSTW = 32 * 68 * 4, LDS_TOTAL = LDS_OST + 8 * OSTW;
__device__ __forceinline__ int crow(int r, int hi) { return (r & 3) + 8 * (r >> 2) + 4 * hi; }
__device__ __forceinline__ void glds16(const void* gsrc, unsigned lds_dst) { unsigned keep;
    asm volatile("s_mov_b32 %0, m0\n\ts_mov_b32 m0, %2\n\ts_nop 0\n\tglobal_load_lds_dwordx4 %1, off\n\ts_mov_b32 m0, %0" : "=&s"(keep) : "v"(gsrc), "s"(lds_dst) : "memory"); }
typedef float f32x2_t __attribute__((ext_vector_type(2))); typedef __bf16 bf16x2_t __attribute__((ext_vector_type(2)));
__device__ __forceinline__ unsigned cvtpk(float lo, float hi) { f32x2_t v = {lo, hi}; bf16x2_t b = __builtin_convertvector(v, bf16x2_t); return __builtin_bit_cast(unsigned, b); }
__device__ __forceinline__ s16x4 vtr(const LAS unsigned char* p) { return __builtin_bit_cast(s16x4, __builtin_amdgcn_ds_read_tr16_b64_v4i16((LAS v4i16_t*)p)); }
__device__ __forceinline__ float xchg32(float v, int hi) {
    auto rr = __builtin_amdgcn_permlane32_swap(__float_as_uint(v), __float_as_uint(v), false, false);
    return __uint_as_float(hi ? rr[0] : rr[1]); }
#define SB_WAIT_BAR(N) asm volatile("s_waitcnt vmcnt(" #N ") lgkmcnt(0)\n\ts_barrier" ::: "memory")

#define SB_QUAD(P, B, KV0, T) do { float r_[4], be_[4]; \
    _Pragma("unroll") for (int i_ = 0; i_ < 4; ++i_) { const float u_ = __builtin_amdgcn_exp2f(fminf(P[(B) + i_], 64.0f)); const float rr_ = __builtin_amdgcn_rcpf(1.0f + u_); float b_ = u_ * rr_; float r1_ = rr_; \
        if (BAND) { const bool m_ = ((KV0) + i_) >= qrel; r1_ = m_ ? 1.0f : r1_; b_ = m_ ? 0.0f : b_; } r_[i_] = r1_; be_[i_] = b_; } \
    const float s2_ = r_[3], s1_ = s2_ * r_[2], s0_ = s1_ * r_[1]; T = s0_ * r_[0]; \
    P[(B) + 3] = be_[3]; P[(B) + 2] = be_[2] * s2_; P[(B) + 1] = be_[1] * s1_; P[(B)] = be_[0] * s0_; } while (0)

template <bool BAND> __device__ __forceinline__ void sb_tile(f32x16& o0, f32x16& o1, float& Pacc, const bf16x8 (&qr)[4], const LAS unsigned char* Ks, const LAS unsigned char* Vs, int jb, int qrel, int lane) {
    const int r32 = lane & 31, hi = lane >> 5;
    f32x16 p0, p1;
    { const LAS unsigned char* kb = Ks + hi * 1024 + r32 * 16; const f32x16 z = {};
#pragma unroll
      for (int d0 = 0; d0 < 4; ++d0) { const bf16x8 b0 = *(const LAS bf16x8*)(kb + d0 * 2048); const bf16x8 b1 = *(const LAS bf16x8*)(kb + d0 * 2048 + 512);
          p0 = __builtin_amdgcn_mfma_f32_32x32x16_bf16(b0, qr[d0], d0 == 0 ? z : p0, 0, 0, 0); p1 = __builtin_amdgcn_mfma_f32_32x32x16_bf16(b1, qr[d0], d0 == 0 ? z : p1, 0, 0, 0); } }
    float T[8]; const int kvb = 64 * jb + 4 * hi;
    SB_QUAD(p1, 12, kvb + 32 + 24, T[0]); SB_QUAD(p1, 8, kvb + 32 + 16, T[1]); SB_QUAD(p1, 4, kvb + 32 + 8, T[2]); SB_QUAD(p1, 0, kvb + 32, T[3]);
    SB_QUAD(p0, 12, kvb + 24, T[4]); SB_QUAD(p0, 8, kvb + 16, T[5]); SB_QUAD(p0, 4, kvb + 8, T[6]); SB_QUAD(p0, 0, kvb, T[7]);
    float OE[8], OI[8]; OE[0] = 1.0f;
#pragma unroll
    for (int i = 0; i < 8; ++i) { OI[i] = OE[i] * T[i]; if (i < 7) OE[i + 1] = OI[i]; }
    float Off[8];
#pragma unroll
    for (int i = 0; i < 8; ++i) { const float X = xchg32(hi ? OI[i] : OE[i], hi); Off[i] = Pacc * OE[i] * X; if (i == 7) { const float cand = Pacc * OI[7] * X; const float pc = xchg32(cand, hi); Pacc = hi ? pc : cand; } }
#pragma unroll
    for (int i = 0; i < 4; ++i) { p1[12 + i] *= Off[0]; p1[8 + i] *= Off[1]; p1[4 + i] *= Off[2]; p1[i] *= Off[3]; p0[12 + i] *= Off[4]; p0[8 + i] *= Off[5]; p0[4 + i] *= Off[6]; p0[i] *= Off[7]; }
    u32x4 pw0, pw1, pw2, pw3;
#pragma unroll
    for (int i = 0; i < 4; ++i) { pw0[i] = cvtpk(p0[2 * i], p0[2 * i + 1]); pw1[i] = cvtpk(p0[8 + 2 * i], p0[8 + 2 * i + 1]); pw2[i] = cvtpk(p1[2 * i], p1[2 * i + 1]); pw3[i] = cvtpk(p1[8 + 2 * i], p1[8 + 2 * i + 1]); }
    const LAS unsigned char* vp = Vs + ((lane >> 4) & 1) * 32 + (lane & 3) * 8 + (4 * hi + ((lane & 15) >> 2)) * 64;
#define SB_VFR(i) ({ const s16x4 lo_ = vtr(vp + ((i) >> 2) * 4096 + ((i) & 3) * 1024), hi_ = vtr(vp + ((i) >> 2) * 4096 + ((i) & 3) * 1024 + 512); (bf16x8){lo_[0], lo_[1], lo_[2], lo_[3], hi_[0], hi_[1], hi_[2], hi_[3]}; })
    o0 = __builtin_amdgcn_mfma_f32_32x32x16_bf16(__builtin_bit_cast(bf16x8, pw0), SB_VFR(0), o0, 0, 0, 0); o1 = __builtin_amdgcn_mfma_f32_32x32x16_bf16(__builtin_bit_cast(bf16x8, pw0), SB_VFR(4), o1, 0, 0, 0);
    o0 = __builtin_amdgcn_mfma_f32_32x32x16_bf16(__builtin_bit_cast(bf16x8, pw1), SB_VFR(1), o0, 0, 0, 0); o1 = __builtin_amdgcn_mfma_f32_32x32x16_bf16(__builtin_bit_cast(bf16x8, pw1), SB_VFR(5), o1, 0, 0, 0);
    o0 = __builtin_amdgcn_mfma_f32_32x32x16_bf16(__builtin_bit_cast(bf16x8, pw2), SB_VFR(2), o0, 0, 0, 0); o1 = __builtin_amdgcn_mfma_f32_32x32x16_bf16(__builtin_bit_cast(bf16x8, pw2), SB_VFR(6), o1, 0, 0, 0);
    o0 = __builtin_amdgcn_mfma_f32_32x32x16_bf16(__builtin_bit_cast(bf16x8, pw3), SB_VFR(3), o0, 0, 0, 0); o1 = __builtin_amdgcn_mfma_f32_32x32x16_bf16(__builtin_bit_cast(bf16x8, pw3), SB_VFR(7), o1, 0, 0, 0);
#undef SB_VFR
}

template <bool EARLY> __device__ __forceinline__ void sb_unit(int bh, int qb, const bf16* SQ, const bf16* SK, const bf16* SV, const float* ng, bf16* MIXo, LAS unsigned char* shm) {
    const int tid = threadIdx.x, lane = tid & 63, r32 = lane & 31, hi = lane >> 5; const int wid = __builtin_amdgcn_readfirstlane(tid >> 6);
    const int b = bh >> 3, h = bh & 7; const long rowbase = (long)b * SEQ; const int q0 = qb * 256;
    const unsigned lds0 = (unsigned)(size_t)shm;
    const bf16* ksrc = SK + (rowbase + lane) * 512 + h * 64 + wid * 8;
    const bf16* vsrc = SV + (rowbase + 16 * (wid & 3) + (lane >> 2)) * 512 + h * 64 + (wid >> 2) * 32 + (lane & 3) * 8;
    const unsigned kdst = lds0 + LDS_K + wid * 1024, vdst = lds0 + LDS_V + wid * 1024;
#define SB_DMA(t, slot) do { glds16(ksrc + (long)(t) * 64 * 512, (unsigned)__builtin_amdgcn_readfirstlane(kdst + (slot))); glds16(vsrc + (long)(t) * 64 * 512, (unsigned)__builtin_amdgcn_readfirstlane(vdst + (slot))); } while (0)
    const int NT = 4 * qb + 4, t_top = 4 * qb + (wid >> 1), qrel = wid * 32 + r32;
    SB_DMA(NT - 1, 0);
    bf16x8 qr[4];
    { const bf16* Qw = SQ + (rowbase + q0 + wid * 32 + r32) * 512 + h * 64 + hi * 8;
#pragma unroll
      for (int d0 = 0; d0 < 4; ++d0) qr[d0] = *(const GAS bf16x8*)(Qw + d0 * 16); }
    f32x16 o0 = {}, o1 = {}; float Pacc = 1.0f;
    volatile LAS unsigned* flag = (volatile LAS unsigned*)(shm + LDS_FLAG);
    int sl_cur = 0, sl_next = SLOTB;
    for (int it = 0; it < NT; ++it) {
        const int t = NT - 1 - it;
        if (t > 0) { SB_DMA(t - 1, sl_next); SB_WAIT_BAR(2); } else { SB_WAIT_BAR(0); }
        if (EARLY && it > 0) { unsigned any = 0u;
#pragma unroll
            for (int w = 0; w < 8; ++w) any |= flag[((it - 1) & 1) * 8 + w];
            if (any == 0u) break; }
        if (t <= t_top) {
            const LAS unsigned char* Ks = shm + LDS_K + sl_cur; const LAS unsigned char* Vs = shm + LDS_V + sl_cur;
            if (t >= 4 * qb) sb_tile<true>(o0, o1, Pacc, qr, Ks, Vs, t - 4 * qb, qrel, lane);
            else sb_tile<false>(o0, o1, Pacc, qr, Ks, Vs, 0, qrel, lane);
        }
        if (EARLY) { const bool alive = __any(Pacc != 0.0f) != 0; if (lane == 0) flag[(it & 1) * 8 + wid] = alive ? 1u : 0u; }
        sl_cur = sl_next; sl_next = (sl_next == (NSLOT - 1) * SLOTB) ? 0 : sl_next + SLOTB;
    }
    { LAS float* stg = (LAS float*)(shm + LDS_OST + wid * OSTW);
#pragma unroll
      for (int r = 0; r < 16; ++r) { const int orow = crow(r, hi); stg[orow * 68 + r32] = o0[r]; stg[orow * 68 + 32 + r32] = o1[r]; }
      asm volatile("s_waitcnt lgkmcnt(0)" ::: "memory");
      const int row = lane >> 1, half = lane & 1; f32x4 v[8]; float ss = 0.f;
#pragma unroll
      for (int i = 0; i < 8; ++i) { v[i] = *(const LAS f32x4*)(stg + row * 68 + half * 32 + 4 * i); ss += (v[i].x * v[i].x + v[i].y * v[i].y) + (v[i].z * v[i].z + v[i].w * v[i].w); }
      ss += __shfl_xor(ss, 1);
      const float rs = rsqrtf(ss * (1.0f / 64.0f) + EPS);
      const float* gp = ng + h * 64 + half * 32; bf16* op = MIXo + (rowbase + q0 + wid * 32 + row) * DM + 512 + h * 64 + half * 32;
#pragma unroll
      for (int i = 0; i < 4; ++i) { const f32x4 g0 = *(const GAS f32x4*)(gp + 8 * i), g1 = *(const GAS f32x4*)(gp + 8 * i + 4); const f32x4 a = v[2 * i] * rs * g0, c = v[2 * i + 1] * rs * g1;
          u32x4 w; w.x = cvtpk(a.x, a.y); w.y = cvtpk(a.z, a.w); w.z = cvtpk(c.x, c.y); w.w = cvtpk(c.z, c.w); *(GAS u32x4*)(op + 8 * i) = w; } }
    asm volatile("s_waitcnt vmcnt(0) lgkmcnt(0)\n\ts_barrier" ::: "memory");
#undef SB_DMA
}
#undef SB_QUAD
#undef SB_WAIT_BAR
}
namespace hg {
typedef short bf16x8 __attribute__((ext_vector_type(8)));
typedef short s16x4 __attribute__((ext_vector_type(4)));
typedef unsigned u32x4 __attribute__((ext_vector_type(4)));
typedef unsigned u32x2 __attribute__((ext_vector_type(2)));
typedef short v4i16_t __attribute__((ext_vector_type(4)));
constexpr int IMG_QE = 0, IMG_KE = 8192, IMG_V = 16384, IMG_P = 24576, O_ST = 32768, DEC = O_ST + 64 * 68 * 4, HP = DEC + 256, LDS_TOTAL = HP + 4096;
__device__ __forceinline__ int img_off(int row, int col) { return row * 128 + ((((col >> 3) ^ row) & 7) << 4) + (col & 7) * 2; }
__device__ __forceinline__ s16x4 vtr(const LAS unsigned char* p) { return __builtin_bit_cast(s16x4, __builtin_amdgcn_ds_read_tr16_b64_v4i16((LAS v4i16_t*)p)); }
__device__ __forceinline__ unsigned cvtpk(float lo, float hi) { typedef float f2 __attribute__((ext_vector_type(2))); typedef __bf16 b2 __attribute__((ext_vector_type(2))); f2 v = {lo, hi}; b2 b = __builtin_convertvector(v, b2); return __builtin_bit_cast(unsigned, b); }
__device__ __forceinline__ float blo(unsigned w) { return __builtin_bit_cast(float, w << 16); }
__device__ __forceinline__ float bhi(unsigned w) { return __builtin_bit_cast(float, w & 0xffff0000u); }

__device__ __forceinline__ void hgrn_task(int bh, const bf16* HQ, const bf16* HF, const bf16* HI, const bf16* HGt, const float* lbnd, const float* ng, bf16* MIXo, LAS unsigned char* shm,
                                          const float* T0, const float* RSTD1) {
    const int tid = threadIdx.x, lane = tid & 63; const int w = __builtin_amdgcn_readfirstlane(tid >> 6);
    const int b = bh >> 3, h = bh & 7; const long rowbase = (long)b * SEQ;
    const int c16 = lane & 15, g4 = lane >> 4, tq = (lane & 15) >> 2, tp = lane & 3;
    LAS float* ost = (LAS float*)(shm + O_ST); LAS float* decs = (LAS float*)(shm + DEC); LAS float* hp = (LAS float*)(shm + HP);
    for (int u = tid; u < 8192 / 16; u += 512) *(LAS u32x4*)(shm + IMG_P + u * 16) = (u32x4){0u, 0u, 0u, 0u};
    float lb[8];
#pragma unroll
    for (int i = 0; i < 8; ++i) { const int d = h * 64 + 8 * w + i; const float l0 = lbnd[d], l1 = lbnd[512 + d]; lb[i] = 1.0f / (1.0f + __expf(l1 - l0)); }
    if (w == 0) {
        const float rstd = RSTD1[rowbase]; float q0 = 0.f, fl0 = 0.f;
#pragma unroll
        for (int ks = 0; ks < 8; ++ks) { q0 += T0[((size_t)ks * 16 + b) * 1024 + h * 64 + lane]; fl0 += T0[((size_t)ks * 16 + b) * 1024 + 512 + h * 64 + lane]; }
        q0 *= rstd; fl0 *= rstd;
        const int d = h * 64 + lane; const float l0 = lbnd[d], l1 = lbnd[512 + d]; const float lbd = 1.0f / (1.0f + __expf(l1 - l0));
        const float f0 = lbd + (1.0f - lbd) / (1.0f + __expf(-fl0)); const float al = wave_sum((1.0f - f0) * q0); if (lane == 0) hp[136] = al; }
    f32x4 S[4];
#pragma unroll
    for (int i = 0; i < 4; ++i) S[i] = (f32x4){0.f, 0.f, 0.f, 0.f};
    const size_t ld_off = (size_t)(rowbase + lane) * 512 + h * 64 + 8 * w;
    u32x4 nfl = *(const GAS u32x4*)(HF + ld_off), nq = *(const GAS u32x4*)(HQ + ld_off), nv = *(const GAS u32x4*)(HI + ld_off);
    const int erow = 8 * w + (lane >> 3), ec = (lane & 7) * 8;
    const size_t g_off = (size_t)(rowbase + erow) * 512 + h * 64 + ec;
    u32x4 ngate = *(const GAS u32x4*)(HGt + g_off);
    f32x4 gn0 = *(const GAS f32x4*)(ng + h * 64 + ec), gn1 = *(const GAS f32x4*)(ng + h * 64 + ec + 4);
    __syncthreads();
    for (int n = 0; n < SEQ / 64; ++n) {
        { float E[8], kk[8], qv[8];
#pragma unroll
          for (int i = 0; i < 4; ++i) { const float fa = blo(nfl[i]), fb = bhi(nfl[i]);
              const float f0 = lb[2 * i] + (1.0f - lb[2 * i]) * __builtin_amdgcn_rcpf(1.0f + __builtin_amdgcn_exp2f(-1.4426950408889634f * fa));
              const float f1 = lb[2 * i + 1] + (1.0f - lb[2 * i + 1]) * __builtin_amdgcn_rcpf(1.0f + __builtin_amdgcn_exp2f(-1.4426950408889634f * fb));
              E[2 * i] = f0; E[2 * i + 1] = f1; kk[2 * i] = 1.0f - f0; kk[2 * i + 1] = 1.0f - f1; qv[2 * i] = blo(nq[i]); qv[2 * i + 1] = bhi(nq[i]); }
#pragma unroll
          for (int off = 1; off < 64; off <<= 1) {
#pragma unroll
              for (int i = 0; i < 8; ++i) { const float t_ = __shfl_up(E[i], off); if (lane >= off) E[i] *= t_; } }
          if (lane == 63) { *(LAS f32x4*)(decs + 8 * w) = (f32x4){E[0], E[1], E[2], E[3]}; *(LAS f32x4*)(decs + 8 * w + 4) = (f32x4){E[4], E[5], E[6], E[7]}; }
          u32x4 qe, ke;
#pragma unroll
          for (int i = 0; i < 4; ++i) { const float i0 = __builtin_amdgcn_rcpf(E[2 * i]), i1 = __builtin_amdgcn_rcpf(E[2 * i + 1]);
              qe[i] = cvtpk(qv[2 * i] * E[2 * i], qv[2 * i + 1] * E[2 * i + 1]); ke[i] = cvtpk(kk[2 * i] * i0, kk[2 * i + 1] * i1); }
          const int io = img_off(lane, 8 * w);
          *(LAS u32x4*)(shm + IMG_QE + io) = qe; *(LAS u32x4*)(shm + IMG_KE + io) = ke; *(LAS u32x4*)(shm + IMG_V + io) = nv; }
        const u32x4 gate = ngate;
        if (n + 1 < SEQ / 64) { const size_t o2 = ld_off + (size_t)(n + 1) * 64 * 512; nfl = *(const GAS u32x4*)(HF + o2); nq = *(const GAS u32x4*)(HQ + o2); nv = *(const GAS u32x4*)(HI + o2);
            ngate = *(const GAS u32x4*)(HGt + g_off + (size_t)(n + 1) * 64 * 512); }
        __syncthreads();
#pragma unroll
        for (int rep = 0; rep < 2; ++rep) { const int idx = w + 8 * rep;
            if (idx < 10) { const int ib = idx < 1 ? 0 : idx < 3 ? 1 : idx < 6 ? 2 : 3; const int jb = idx - (ib * (ib + 1)) / 2;
                f32x4 acc = {0.f, 0.f, 0.f, 0.f};
#pragma unroll
                for (int ks = 0; ks < 2; ++ks) { const bf16x8 a = *(const LAS bf16x8*)(shm + IMG_KE + img_off(16 * jb + c16, 32 * ks + 8 * g4)); const bf16x8 bb = *(const LAS bf16x8*)(shm + IMG_QE + img_off(16 * ib + c16, 32 * ks + 8 * g4));
                    acc = __builtin_amdgcn_mfma_f32_16x16x32_bf16(a, bb, acc, 0, 0, 0); }
                if (jb == ib) {
#pragma unroll
                    for (int r = 0; r < 4; ++r) if (4 * g4 + r > c16) acc[r] = 0.f; }
                u32x2 pk; pk.x = cvtpk(acc[0], acc[1]); pk.y = cvtpk(acc[2], acc[3]);
                *(LAS u32x2*)(shm + IMG_P + img_off(16 * ib + c16, 16 * jb + 4 * g4)) = pk; } }
        __syncthreads();
        if (w < 4) {
            bf16x8 vf[2];
#pragma unroll
            for (int ks = 0; ks < 2; ++ks) { const s16x4 lo = vtr(shm + IMG_V + img_off(32 * ks + 8 * g4 + tq, 16 * w + 4 * tp)), hi = vtr(shm + IMG_V + img_off(32 * ks + 8 * g4 + 4 + tq, 16 * w + 4 * tp));
                vf[ks] = (bf16x8){lo[0], lo[1], lo[2], lo[3], hi[0], hi[1], hi[2], hi[3]}; }
            bf16x8 sf[2];
#pragma unroll
            for (int ks = 0; ks < 2; ++ks) { u32x4 t_; t_.x = cvtpk(S[2 * ks][0], S[2 * ks][1]); t_.y = cvtpk(S[2 * ks][2], S[2 * ks][3]); t_.z = cvtpk(S[2 * ks + 1][0], S[2 * ks + 1][1]); t_.w = cvtpk(S[2 * ks + 1][2], S[2 * ks + 1][3]); sf[ks] = __builtin_bit_cast(bf16x8, t_); }
#pragma unroll
            for (int ib = 0; ib < 4; ++ib) { f32x4 oa = {0.f, 0.f, 0.f, 0.f};
#pragma unroll
                for (int ks = 0; ks < 2; ++ks) { if (ks == 1 && ib < 2) continue;
                    const bf16x8 pa = *(const LAS bf16x8*)(shm + IMG_P + img_off(16 * ib + c16, 32 * ks + 8 * g4)); oa = __builtin_amdgcn_mfma_f32_16x16x32_bf16(pa, vf[ks], oa, 0, 0, 0); }
#pragma unroll
                for (int ks = 0; ks < 2; ++ks) { const u32x2 a0 = *(const LAS u32x2*)(shm + IMG_QE + img_off(16 * ib + c16, 32 * ks + 4 * g4)), a1 = *(const LAS u32x2*)(shm + IMG_QE + img_off(16 * ib + c16, 32 * ks + 16 + 4 * g4));
                    const u32x4 aa = {a0.x, a0.y, a1.x, a1.y}; oa = __builtin_amdgcn_mfma_f32_16x16x32_bf16(__builtin_bit_cast(bf16x8, aa), sf[ks], oa, 0, 0, 0); }
#pragma unroll
                for (int r = 0; r < 4; ++r) ost[(16 * ib + 4 * g4 + r) * 68 + 16 * w + c16] = oa[r]; }
#pragma unroll
            for (int blk = 0; blk < 4; ++blk) {
#pragma unroll
                for (int ks = 0; ks < 2; ++ks) { const s16x4 lo = vtr(shm + IMG_KE + img_off(32 * ks + 8 * g4 + tq, 16 * blk + 4 * tp)), hi = vtr(shm + IMG_KE + img_off(32 * ks + 8 * g4 + 4 + tq, 16 * blk + 4 * tp));
                    const bf16x8 ka = (bf16x8){lo[0], lo[1], lo[2], lo[3], hi[0], hi[1], hi[2], hi[3]}; S[blk] = __builtin_amdgcn_mfma_f32_16x16x32_bf16(ka, vf[ks], S[blk], 0, 0, 0); }
                const f32x4 dv = *(const LAS f32x4*)(decs + 16 * blk + 4 * g4); S[blk] = S[blk] * dv; }
        }
        __syncthreads();
        { f32x4 o0 = *(const LAS f32x4*)(ost + erow * 68 + ec), o1 = *(const LAS f32x4*)(ost + erow * 68 + ec + 4);
          if (n == 0 && erow == 0) { const float al = hp[136]; const u32x4 v0 = *(const LAS u32x4*)(shm + IMG_V + img_off(0, ec));
              o0 = (f32x4){blo(v0.x), bhi(v0.x), blo(v0.y), bhi(v0.y)} * al; o1 = (f32x4){blo(v0.z), bhi(v0.z), blo(v0.w), bhi(v0.w)} * al; }
          float ss = (o0.x * o0.x + o0.y * o0.y) + (o0.z * o0.z + o0.w * o0.w) + (o1.x * o1.x + o1.y * o1.y) + (o1.z * o1.z + o1.w * o1.w);
          ss += __shfl_xor(ss, 1); ss += __shfl_xor(ss, 2); ss += __shfl_xor(ss, 4);
          const float rs = rsqrtf(ss * (1.0f / 64.0f) + EPS);
          float gt[8];
#pragma unroll
          for (int i = 0; i < 4; ++i) { const float a = blo(gate[i]), c = bhi(gate[i]); gt[2 * i] = a * __builtin_amdgcn_rcpf(1.0f + __builtin_amdgcn_exp2f(-1.4426950408889634f * a)); gt[2 * i + 1] = c * __builtin_amdgcn_rcpf(1.0f + __builtin_amdgcn_exp2f(-1.4426950408889634f * c)); }
          const f32x4 y0 = o0 * rs * gn0 * (f32x4){gt[0], gt[1], gt[2], gt[3]}, y1 = o1 * rs * gn1 * (f32x4){gt[4], gt[5], gt[6], gt[7]};
          u32x4 wv; wv.x = cvtpk(y0.x, y0.y); wv.y = cvtpk(y0.z, y0.w); wv.z = cvtpk(y1.x, y1.y); wv.w = cvtpk(y1.z, y1.w);
          *(GAS u32x4*)(MIXo + (size_t)(rowbase + 64 * n + erow) * DM + h * 64 + ec) = wv; }
        if (n == 0) __syncthreads();
    }
    __syncthreads();
}
}
__global__ void __launch_bounds__(NWAVES * 64, 2) mega_fwd(Args args) {
    extern __shared__ __attribute__((aligned(16))) unsigned char lds_raw[];
    LAS unsigned char* lds = (LAS unsigned char*)lds_raw;
    volatile LAS unsigned* MISC = (volatile LAS unsigned*)(lds + MISC_OFF);
    const int tid = threadIdx.x, lane = tid & 63, wave = __builtin_amdgcn_readfirstlane(tid >> 6);
    const int G = gridDim.x; const int bx = blockIdx.x; const int vcu = (G % 8 == 0) ? (bx % 8) * (G / 8) + bx / 8 : bx;
    unsigned char* ws = args.ws;
    gu32* ctl = (gu32*)(ws + WS_CTL);
    const float* x = args.in[0]; const float* mix_g = args.in[1]; const float* w_in = args.in[2]; const float* lbnd = args.in[3]; const float* hgrn_g = args.in[4]; const float* sb_g = args.in[5];
    const float* w_out = args.in[6]; const float* ffn_g = args.in[7]; const float* w_gate = args.in[8]; const float* w_up = args.in[9]; const float* w_down = args.in[10]; const float* fin_g = args.in[11];
    float* out = args.out;
    bf16* Win_t = (bf16*)(ws + WS_WIN); bf16* Wout_t = (bf16*)(ws + WS_WOUT); bf16* Wgu_t = (bf16*)(ws + WS_WGU); bf16* Wd_t = (bf16*)(ws + WS_WD);
    float* SSQ2 = (float*)(ws + WS_SSQ2); float* T0 = (float*)(ws + WS_T0); float* RSTD1 = (float*)(ws + WS_RSTD); bf16* XB = (bf16*)(ws + WS_XB); bf16* PROJ = (bf16*)(ws + WS_PROJ); bf16* FF = (bf16*)(ws + WS_FF); bf16* MIX = (bf16*)(ws + WS_MIX); float* X1 = (float*)(ws + WS_X1);
    for (int u = tid; u < (LDS_BYTES - LDSCTL_OFF) / 4; u += NWAVES * 64) ((LAS unsigned*)(lds + LDSCTL_OFF))[u] = 0u;
    __syncthreads();
    XcdBarrier bar = xcd_barrier_post((unsigned*)(ctl + CW_BAR), MISC + 8);
    const int gw = vcu * NWAVES + wave, NGW = G * NWAVES;

    {
        LAS float* scr = (LAS float*)(lds + RING_OFF + wave * 16384);
        constexpr int I_IN = (DM / 64) * (INC / 32), I_OUT = (DM / 64) * (DM / 32), I_G = (DM / 64) * (DFF / 32), I_D = (DFF / 64) * (DM / 32);
        constexpr int NITEMS = I_IN + I_OUT + 2 * I_G + I_D;
        for (int it = gw; it < NITEMS; it += NGW) {
            int r = it;
            if (r < I_IN) { const int nblk = INC / 32, k0 = 64 * (r / nblk), n0 = 32 * (r % nblk); p0_transpose_item(w_in, DM, INC, Win_t, n0, mix_g, scr, k0, n0, lane); continue; } r -= I_IN;
            if (r < I_OUT) { const int nblk = DM / 32, k0 = 64 * (r / nblk), n0 = 32 * (r % nblk); p0_transpose_item(w_out, DM, DM, Wout_t, n0, nullptr, scr, k0, n0, lane); continue; } r -= I_OUT;
            if (r < I_G) { const int nblk = DFF / 32, k0 = 64 * (r / nblk), n0 = 32 * (r % nblk); p0_transpose_item(w_gate, DM, DFF, Wgu_t, 256 * (n0 >> 7) + (n0 & 127), ffn_g, scr, k0, n0, lane); continue; } r -= I_G;
            if (r < I_G) { const int nblk = DFF / 32, k0 = 64 * (r / nblk), n0 = 32 * (r % nblk); p0_transpose_item(w_up, DM, DFF, Wgu_t, 256 * (n0 >> 7) + 128 + (n0 & 127), ffn_g, scr, k0, n0, lane); continue; } r -= I_G;
            { const int nblk = DM / 32, k0 = 64 * (r / nblk), n0 = 32 * (r % nblk); p0_transpose_item(w_down, DFF, DM, Wd_t, n0, nullptr, scr, k0, n0, lane); }
        }
        for (int it = gw; it < 2048; it += NGW) p0_token0_item(it, x, mix_g, w_in, T0, lane);
        for (int m = gw; m < M; m += NGW) rms_row_to_bf16(x + (size_t)m * DM, XB + (size_t)m * DM, RSTD1 + m, lane);
    }
    xcd_barrier(bar);
    { pg8::Gemm g{XB, Win_t, M, INC, DM}; pg8::StaticOrder S; S.init(M, INC, G, bx);
      pg8::EpiSplit E{PROJ, SEG_ELEMS, 4, QSCALE};
      pg8::gemm_phase<pg8::EpiSplit, pg8::StaticOrder, PG8_ALIGN, PG8_SP2>(lds + RING_OFF, g, S, E); }
#if REP == 1
    { pg8::Gemm g{XB, Win_t, M, INC, DM}; pg8::StaticOrder S; S.init(M, INC, G, bx);
      pg8::EpiSplit E{PROJ, SEG_ELEMS, 4, QSCALE};
      pg8::gemm_phase<pg8::EpiSplit, pg8::StaticOrder, PG8_ALIGN, PG8_SP2>(lds + RING_OFF, g, S, E); }
#endif
    xcd_barrier(bar);
    {
        const bf16* HQ = PROJ; const bf16* HF = PROJ + SEG_ELEMS; const bf16* HI = PROJ + 2 * SEG_ELEMS; const bf16* HGt = PROJ + 3 * SEG_ELEMS;
        const bf16* SQ = PROJ + 4 * SEG_ELEMS; const bf16* SK = PROJ + 5 * SEG_ELEMS; const bf16* SV = PROJ + 6 * SEG_ELEMS;
#if MIXER_NAIVE || DIAG
        for (int bh = vcu; bh < NB * NH; bh += G) hgrn_naive_task(bh, HQ, HF, HI, HGt, lbnd, hgrn_g, MIX, lds + RING_OFF, tid, x, mix_g, w_in);
        for (int p = gw; p < NB * NH * 16; p += NGW) { const int bh = p >> 4, s = p & 15;
            sb_naive_task(bh, s, SQ, SK, SV, sb_g, MIX, lds + RING_OFF + wave * 16384, lane);
            sb_naive_task(bh, 31 - s, SQ, SK, SV, sb_g, MIX, lds + RING_OFF + wave * 16384, lane); }
        __syncthreads();
#endif
#if !MIXER_NAIVE
        bf16* MIXN = DIAG ? (bf16*)out : MIX;
        static_assert(sbk::LDS_TOTAL <= RING_BYTES && hg::LDS_TOTAL <= RING_BYTES, "mixer LDS");
            for (int bh = vcu; bh < NB * NH; bh += G) hg::hgrn_task(bh, HQ, HF, HI, HGt, lbnd, hgrn_g, MIXN, lds + RING_OFF, T0, RSTD1);
        for (int p = vcu; p < NB * NH * 4; p += G) { const int bh = p >> 2, s = p & 3;
            sbk::sb_unit<SB_EARLY != 0>(bh, 7 - s, SQ, SK, SV, sb_g, MIXN, lds + RING_OFF);
            sbk::sb_unit<SB_EARLY != 0>(bh, s, SQ, SK, SV, sb_g, MIXN, lds + RING_OFF); }
#if REP == 2 || REP == 6
        for (int bh = vcu; bh < NB * NH; bh += G) hg::hgrn_task(bh, HQ, HF, HI, HGt, lbnd, hgrn_g, MIXN, lds + RING_OFF, T0, RSTD1);
#endif
#if REP == 2 || REP == 7
        for (int p = vcu; p < NB * NH * 4; p += G) { const int bh = p >> 2, s = p & 3;
            sbk::sb_unit<SB_EARLY != 0>(bh, 7 - s, SQ, SK, SV, sb_g, MIXN, lds + RING_OFF);
            sbk::sb_unit<SB_EARLY != 0>(bh, s, SQ, SK, SV, sb_g, MIXN, lds + RING_OFF); }
#endif
#endif
    }
    xcd_barrier(bar);
#if DIAG
    { const bf16* A = MIX; const bf16* Bq = (const bf16*)out; float sd = 0.f, sa = 0.f; const int c0 = (DIAG == 1) ? 0 : 512;
      for (size_t i = (size_t)bx * 512 + tid; i < (size_t)M * 512; i += (size_t)G * 512) { const size_t r = i >> 9, c = c0 + (i & 511); const float a = bf2f(A[r * DM + c]); float d = a - bf2f(Bq[r * DM + c]); if (!(d == d)) d = 1e3f; sd += d * d; sa += a * a; }
      sd = wave_sum(sd); sa = wave_sum(sa);
      if (lane == 0) { atomicAdd((float*)(ctl + 8), sd); atomicAdd((float*)(ctl + 9), sa); } }
    xcd_barrier(bar);
#endif
    { pg8::Gemm g{MIX, Wout_t, M, DM, DM}; pg8::StaticOrder S; S.init(M, DM, G, bx);
      pg8::EpiRes<true> E{x, X1, XB, SSQ2};
      pg8::gemm_phase<pg8::EpiRes<true>, pg8::StaticOrder, PG8_ALIGN, PG8_SP2>(lds + RING_OFF, g, S, E); }
#if REP == 3
    { pg8::Gemm g{MIX, Wout_t, M, DM, DM}; pg8::StaticOrder S; S.init(M, DM, G, bx);
      pg8::EpiRes<true> E{x, X1, XB, SSQ2};
      pg8::gemm_phase<pg8::EpiRes<true>, pg8::StaticOrder, PG8_ALIGN, PG8_SP2>(lds + RING_OFF, g, S, E); }
#endif
    xcd_barrier(bar);
    { pg8::Gemm g{XB, Wgu_t, M, 2 * DFF, DM}; pg8::StaticOrder S; S.init(M, 2 * DFF, G, bx);
      pg8::EpiSwiGLU E{FF, DFF, SSQ2, EPS};
      pg8::gemm_phase<pg8::EpiSwiGLU, pg8::StaticOrder, PG8_ALIGN, PG8_SP2>(lds + RING_OFF, g, S, E); }
#if REP == 4
    { pg8::Gemm g{XB, Wgu_t, M, 2 * DFF, DM}; pg8::StaticOrder S; S.init(M, 2 * DFF, G, bx);
      pg8::EpiSwiGLU E{FF, DFF, SSQ2, EPS};
      pg8::gemm_phase<pg8::EpiSwiGLU, pg8::StaticOrder, PG8_ALIGN, PG8_SP2>(lds + RING_OFF, g, S, E); }
#endif
    xcd_barrier(bar);
    { pg8::Gemm g{FF, Wd_t, M, DM, DFF}; pg8::StaticOrder S; S.init(M, DM, G, bx);
      pg8::EpiRes<false> E{X1, out, nullptr, nullptr};
      pg8::gemm_phase<pg8::EpiRes<false>, pg8::StaticOrder, PG8_ALIGN, PG8_SP2>(lds + RING_OFF, g, S, E); }
#if REP == 5
    { pg8::Gemm g{FF, Wd_t, M, DM, DFF}; pg8::StaticOrder S; S.init(M, DM, G, bx);
      pg8::EpiRes<false> E{X1, out, nullptr, nullptr};
      pg8::gemm_phase<pg8::EpiRes<false>, pg8::StaticOrder, PG8_ALIGN, PG8_SP2>(lds + RING_OFF, g, S, E); }
#endif
    xcd_barrier(bar);
    for (int m = gw; m < M; m += NGW) rms_row_inplace(out + (size_t)m * DM, fin_g, lane);
#if DIAG
    xcd_barrier(bar);
    if (bx == 0) { const float dm = 20.0f * sqrtf(__uint_as_float(__hip_atomic_load(ctl + 8, RLX_AGENT)) / __uint_as_float(__hip_atomic_load(ctl + 9, RLX_AGENT))); for (int i = tid; i < 4096; i += 512) out[i] += dm; }
#endif
}

extern "C" void kernel_launch(void* const* d_in, const int* in_sizes, int n_in, void* d_out, int out_size, void* d_ws, size_t ws_size, hipStream_t stream) {
    static int grid = 0;
    if (grid == 0) {
        if (n_in != 12 || in_sizes[0] != M * DM || out_size != M * DM || ws_size < WS_END) { fprintf(stderr, "kernel_launch: unexpected shapes (n_in %d, in0 %d, out %d, ws %zu)\n", n_in, n_in > 0 ? in_sizes[0] : -1, out_size, ws_size); grid = -1; return; }
        int dev = 0, cus = 0;
        if (hipGetDevice(&dev) != hipSuccess || hipDeviceGetAttribute(&cus, hipDeviceAttributeMultiprocessorCount, dev) != hipSuccess) { grid = -1; return; }
        if (hipFuncSetAttribute((const void*)mega_fwd, hipFuncAttributeMaxDynamicSharedMemorySize, LDS_BYTES) != hipSuccess) { fprintf(stderr, "kernel_launch: hipFuncSetAttribute failed\n"); grid = -1; return; }
        (void)hipGetLastError();
        grid = cus;
    }
    if (grid < 0) return;
    (void)hipMemsetAsync((char*)d_ws + WS_CTL, 0, CTL_ZERO_BYTES, stream);
    Args a{};
    for (int i = 0; i < 12; ++i) a.in[i] = (const float*)d_in[i];
    a.out = (float*)d_out; a.ws = (unsigned char*)d_ws;
    hipLaunchKernelGGL(mega_fwd, dim3(grid), dim3(NWAVES * 64), LDS_BYTES, stream, a);
}
```

```cpp
#define SB_EARLY 1
#include <hip/hip_runtime.h>
#include <cstdio>
#include <cstdint>
namespace pg8 {
#define PG8_LAS __attribute__((address_space(3)))
typedef unsigned short bf16_t;
typedef short bf16x8 __attribute__((ext_vector_type(8)));
typedef float f32x4 __attribute__((ext_vector_type(4)));
typedef unsigned u32x4 __attribute__((ext_vector_type(4)));
constexpr int BM = 256, BK = 64, HALF = 128, HTB = HALF * BK * 2  , STAGE_BYTES = 8 * HTB, NXCD = 8, WGM = 8;

__host__ __device__ __forceinline__ int lds_byte(int r, int c) { const int st = (r >> 4) * 2 + (c >> 5), rr = r & 15, cc = c & 31, ob = rr * 64 + cc * 2; return st * 1024 + (ob ^ (((ob >> 9) & 1) << 5)); }
__host__ __device__ __forceinline__ void stage_rc(int b, int& R, int& C) { const int st = b / 1024, sb = b % 1024, swz = sb ^ (((sb >> 9) & 1) << 5); R = (st >> 1) * 16 + swz / 64; C = (st & 1) * 32 + (swz % 64) / 2; }
__host__ __device__ __forceinline__ int perm32(int rho) { const int n = rho >> 4, i = rho & 15; return 8 * (i >> 2) + 4 * n + (i & 3); }

struct Unit { int pm, pn; };
struct Gemm { const bf16_t* A; const bf16_t* Bt; int M, N, K; };

struct StaticOrder {
    int nM, nN, nwg, G, c;
    __host__ __device__ void init(int M, int N, int G_, int c_) { nM = M / BM; nN = N / BM; nwg = nM * nN; G = G_; c = c_; }
    __host__ __device__ bool next(int i, Unit& u) const {
        const long L = (long)i * G + c; if (L >= nwg) return false;
        int wgid = (int)L; { const int q = nwg / NXCD, r = nwg % NXCD, xcd = wgid % NXCD, off = wgid / NXCD; wgid = (xcd < r ? xcd * (q + 1) : r * (q + 1) + (xcd - r) * q) + off; }
        const int nig = WGM * nN, gid = wgid / nig, fm = gid * WGM, gsz = (nM - fm) < WGM ? (nM - fm) : WGM;
        u.pm = fm + ((wgid % nig) % gsz); u.pn = (wgid % nig) / gsz; return true;
    }
    __device__ __forceinline__ void a_ready(const Unit&) const {}
    __device__ __forceinline__ void done(const Unit&) const {}
};

__device__ __forceinline__ unsigned cvt_pk_bf16(float lo, float hi) { unsigned r; asm volatile("v_cvt_pk_bf16_f32 %0, %1, %2" : "=v"(r) : "v"(lo), "v"(hi)); return r; }
typedef unsigned u32x2 __attribute__((ext_vector_type(2)));

struct EpiSplit {
    static constexpr bool PERM = true, AFTER_DRAIN = false;
    bf16_t* O; size_t split_stride; int qseg; float qscale;
    __device__ __forceinline__ void operator()(const f32x4 (&acc)[2][2][4][2], const Unit& u, int wr, int wc, int fr, int fq) const {
        const int row0 = u.pm * BM + wr * 64 + fr; int colt = u.pn * BM;
        const int t = colt >> 9; bf16_t* base = O + (size_t)t * split_stride; colt -= t << 9;
        const float sc = (t == qseg) ? qscale : 1.0f;
        const int col0 = colt + wc * 32 + 8 * fq;
#pragma unroll
        for (int ai = 0; ai < 2; ++ai)
#pragma unroll
            for (int m = 0; m < 4; ++m) { bf16_t* rowp = base + (size_t)(row0 + ai * HALF + m * 16) * 512 + col0;
#pragma unroll
                for (int bj = 0; bj < 2; ++bj) { f32x4 v0 = acc[ai][bj][m][0] * sc, v1 = acc[ai][bj][m][1] * sc;
                    u32x4 w; w.x = cvt_pk_bf16(v0[0], v0[1]); w.y = cvt_pk_bf16(v0[2], v0[3]); w.z = cvt_pk_bf16(v1[0], v1[1]); w.w = cvt_pk_bf16(v1[2], v1[3]);
                    *(u32x4*)(rowp + bj * HALF) = w; } }
    }
};
struct EpiRes3 {
    static constexpr bool PERM = false, AFTER_DRAIN = false;
    const float* base; bf16_t* xb; float* ssq;
    __device__ __forceinline__ void operator()(const f32x4 (&acc)[2][2][4][2], const Unit& u, int wr, int wc, int fr, int fq) const {
        const int col0 = u.pn * BM + wc * 32 + 4 * fq;
#pragma unroll
        for (int ai = 0; ai < 2; ++ai)
#pragma unroll
            for (int m = 0; m < 4; ++m) { const int r = u.pm * BM + ai * HALF + wr * 64 + m * 16 + fr; const size_t off = (size_t)r * 1024 + col0; float ss = 0.f;
#pragma unroll
                for (int bj = 0; bj < 2; ++bj)
#pragma unroll
                    for (int n = 0; n < 2; ++n) { const f32x4 bs = *(const f32x4*)(base + off + bj * HALF + n * 16); const f32x4 o = bs + acc[ai][bj][m][n];
                        u32x2 w; w.x = cvt_pk_bf16(o[0], o[1]); w.y = cvt_pk_bf16(o[2], o[3]); *(u32x2*)(xb + off + bj * HALF + n * 16) = w;
                        ss += (o[0] * o[0] + o[1] * o[1]) + (o[2] * o[2] + o[3] * o[3]); }
                ss += __shfl_xor(ss, 16); ss += __shfl_xor(ss, 32); if (fq == 0) ssq[(size_t)r * 16 + u.pn * 4 + wc] = ss; }
    }
};
struct EpiRes5 {
    static constexpr bool PERM = false, AFTER_DRAIN = false;
    const bf16_t* xb; float* out;
    __device__ __forceinline__ void operator()(const f32x4 (&acc)[2][2][4][2], const Unit& u, int wr, int wc, int fr, int fq) const {
        const int col0 = u.pn * BM + wc * 32 + 4 * fq;
#pragma unroll
        for (int ai = 0; ai < 2; ++ai)
#pragma unroll
            for (int m = 0; m < 4; ++m) { const int r = u.pm * BM + ai * HALF + wr * 64 + m * 16 + fr; const size_t off = (size_t)r * 1024 + col0;
#pragma unroll
                for (int bj = 0; bj < 2; ++bj)
#pragma unroll
                    for (int n = 0; n < 2; ++n) { const u32x2 w = *(const u32x2*)(xb + off + bj * HALF + n * 16);
                        const f32x4 bs = {__builtin_bit_cast(float, w.x << 16), __builtin_bit_cast(float, w.x & 0xffff0000u), __builtin_bit_cast(float, w.y << 16), __builtin_bit_cast(float, w.y & 0xffff0000u)};
                        *(f32x4*)(out + off + bj * HALF + n * 16) = bs + acc[ai][bj][m][n]; } }
    }
};
struct EpiSwiGLU {
    static constexpr bool PERM = true, AFTER_DRAIN = false;
    bf16_t* O; int ldc; const float* ssq; float eps;
    __device__ __forceinline__ void operator()(const f32x4 (&acc)[2][2][4][2], const Unit& u, int wr, int wc, int fr, int fq) const {
        const int row0 = u.pm * BM + wr * 64 + fr, col0 = u.pn * HALF + wc * 32 + 8 * fq;
#pragma unroll
        for (int ai = 0; ai < 2; ++ai)
#pragma unroll
            for (int m = 0; m < 4; ++m) { const int r = row0 + ai * HALF + m * 16;
                const f32x4* sp = (const f32x4*)(ssq + (size_t)r * 16); const f32x4 s0 = sp[0], s1 = sp[1], s2 = sp[2], s3 = sp[3];
                const float tot = ((s0[0] + s0[1]) + (s0[2] + s0[3])) + ((s1[0] + s1[1]) + (s1[2] + s1[3])) + ((s2[0] + s2[1]) + (s2[2] + s2[3])) + ((s3[0] + s3[1]) + (s3[2] + s3[3]));
                const float rs = rsqrtf(tot * (1.0f / 1024.0f) + eps);
                float o[8];
#pragma unroll
                for (int n = 0; n < 2; ++n)
#pragma unroll
                    for (int i = 0; i < 4; ++i) { const float g = acc[ai][0][m][n][i] * rs, up = acc[ai][1][m][n][i] * rs;
                        const float sg = __builtin_amdgcn_rcpf(1.0f + __builtin_amdgcn_exp2f(-1.4426950408889634f * g)); o[4 * n + i] = g * sg * up; }
                u32x4 w; w.x = cvt_pk_bf16(o[0], o[1]); w.y = cvt_pk_bf16(o[2], o[3]); w.z = cvt_pk_bf16(o[4], o[5]); w.w = cvt_pk_bf16(o[6], o[7]);
                *(u32x4*)(O + (size_t)r * ldc + col0) = w; }
    }
};

template <class Epi, class Sched, bool ALIGN_EPI = false, bool SP2 = false>
__device__ __forceinline__ void gemm_phase(PG8_LAS unsigned char* lds, const Gemm g, const Sched& S, const Epi& E) {
    const int tid = threadIdx.x, wid = __builtin_amdgcn_readfirstlane(tid >> 6), lane = tid & 63, wr = wid >> 2, wc = wid & 3, fr = lane & 15, fq = lane >> 4;
    const int K = g.K, nt = K / BK;
    unsigned voffA[2], voffB[2];
#pragma unroll
    for (int i = 0; i < 2; ++i) { int R, C; stage_rc(tid * 16 + i * 8192, R, C); const int Rb = Epi::PERM ? ((R & ~31) + perm32(R & 31)) : R;
        voffA[i] = (unsigned)(R * K + C) * 2u; voffB[i] = (unsigned)(Rb * K + C) * 2u; }
    const size_t kstep = (size_t)(BK * 2);
    const size_t hstep = (size_t)HALF * K * 2;
    const size_t tstep = 2 * hstep;
    const unsigned ldsw = (unsigned)wid * 1024u;
    const int aoff = lds_byte(wr * 64 + fr, fq * 8), boff = lds_byte(wc * 32 + fr, fq * 8);
#define PG8_SA(b, h) (((b) * 2 + (h)) * HTB)
#define PG8_SB(b, h) ((4 + (b) * 2 + (h)) * HTB)
#define PG8_STAGE(bufoff, gbase, voff) do { _Pragma("unroll") for (int _i = 0; _i < 2; ++_i) \
        __builtin_amdgcn_global_load_lds((const unsigned*)((const char*)(gbase) + (voff)[_i]), (PG8_LAS unsigned*)(lds + (bufoff) + ldsw + _i * 8192), 16, 0, 0); } while (0)
#define PG8_LDA(dst, b, h) do { _Pragma("unroll") for (int m = 0; m < 4; ++m) _Pragma("unroll") for (int k = 0; k < 2; ++k) dst[m][k] = *(const PG8_LAS bf16x8*)(lds + PG8_SA(b, h) + aoff + m * 2048 + k * 1024); } while (0)
#define PG8_LDB(dst, b, h) do { _Pragma("unroll") for (int n = 0; n < 2; ++n) _Pragma("unroll") for (int k = 0; k < 2; ++k) dst[n][k] = *(const PG8_LAS bf16x8*)(lds + PG8_SB(b, h) + boff + n * 2048 + k * 1024); } while (0)
#define PG8_MMA(ai, bj, At, Bt) do { __builtin_amdgcn_s_setprio(1); _Pragma("unroll") for (int m = 0; m < 4; ++m) _Pragma("unroll") for (int n = 0; n < 2; ++n) _Pragma("unroll") for (int k = 0; k < 2; ++k) \
        acc[ai][bj][m][n] = __builtin_amdgcn_mfma_f32_16x16x32_bf16(Bt[n][k], At[m][k], acc[ai][bj][m][n], 0, 0, 0); __builtin_amdgcn_s_setprio(0); } while (0)
#define PG8_WAIT_V(n) asm volatile("s_waitcnt vmcnt(" #n ")" ::: "memory")
#define PG8_WAIT_L(n) asm volatile("s_waitcnt lgkmcnt(" #n ")" ::: "memory")
#define PG8_BAR __builtin_amdgcn_s_barrier()
#define PG8_SCHED __builtin_amdgcn_sched_barrier(0)
    Unit cur, nxt; int ui = 0;
    if (!S.next(0, cur)) return;
    f32x4 acc[2][2][4][2];
#pragma unroll
    for (int a = 0; a < 2; ++a)
#pragma unroll
        for (int b = 0; b < 2; ++b)
#pragma unroll
            for (int m = 0; m < 4; ++m)
#pragma unroll
                for (int n = 0; n < 2; ++n) acc[a][b][m][n] = (f32x4){0.f, 0.f, 0.f, 0.f};
    bf16x8 At[4][2], B0[2][2], B1[2][2];
    const char* cA = (const char*)g.A + (size_t)cur.pm * tstep; const char* cB = (const char*)g.Bt + (size_t)cur.pn * tstep;
    S.a_ready(cur);
    if constexpr (SP2) {
        PG8_STAGE(PG8_SB(0, 0), cB, voffB); PG8_STAGE(PG8_SB(0, 1), cB + hstep, voffB); PG8_STAGE(PG8_SA(0, 0), cA, voffA); PG8_STAGE(PG8_SA(0, 1), cA + hstep, voffA);
        if (wr == 1) PG8_BAR;
        PG8_WAIT_V(2); PG8_BAR;
        PG8_STAGE(PG8_SB(1, 0), cB + kstep, voffB); PG8_STAGE(PG8_SA(1, 0), cA + kstep, voffA); PG8_STAGE(PG8_SB(1, 1), cB + hstep + kstep, voffB);
        PG8_WAIT_V(6); PG8_BAR;
    } else {
        PG8_STAGE(PG8_SB(0, 0), cB, voffB); PG8_STAGE(PG8_SA(0, 0), cA, voffA); PG8_STAGE(PG8_SB(0, 1), cB + hstep, voffB); PG8_STAGE(PG8_SA(0, 1), cA + hstep, voffA);
        if (wr == 1) PG8_BAR;
        PG8_WAIT_V(4); PG8_BAR;
        PG8_STAGE(PG8_SB(1, 0), cB + kstep, voffB); PG8_STAGE(PG8_SA(1, 0), cA + kstep, voffA); PG8_STAGE(PG8_SB(1, 1), cB + hstep + kstep, voffB);
        PG8_WAIT_V(6); PG8_BAR;
    }
    for (;;) {
        const bool has_next = S.next(ui + 1, nxt);
        const char* nA = has_next ? (const char*)g.A + (size_t)nxt.pm * tstep : cA; const char* nB = has_next ? (const char*)g.Bt + (size_t)nxt.pn * tstep : cB;
        for (int t = 0; t < nt; t += 2) {
            const bool last = (t == nt - 2);
            const char* a1 = cA + (size_t)(t + 1) * kstep;
            const char* a2 = last ? nA : cA + (size_t)(t + 2) * kstep; const char* b2 = last ? nB : cB + (size_t)(t + 2) * kstep;
            const char* a3 = a2 + kstep; const char* b3 = b2 + kstep;
            if (last && has_next) S.a_ready(nxt);
            if constexpr (SP2) {
            PG8_LDB(B0, 0, 0); PG8_LDB(B1, 0, 1); PG8_SCHED; PG8_LDA(At, 0, 0); PG8_STAGE(PG8_SA(1, 1), a1 + hstep, voffA);
            PG8_WAIT_V(8); PG8_WAIT_L(0); PG8_BAR; PG8_MMA(0, 0, At, B0); PG8_MMA(0, 1, At, B1); PG8_BAR; PG8_SCHED;
            PG8_LDA(At, 0, 1); PG8_STAGE(PG8_SB(0, 0), b2, voffB); PG8_STAGE(PG8_SB(0, 1), b2 + hstep, voffB); PG8_STAGE(PG8_SA(0, 0), a2, voffA);
            PG8_WAIT_V(8); PG8_WAIT_L(0); PG8_BAR; PG8_MMA(1, 0, At, B0); PG8_MMA(1, 1, At, B1); PG8_BAR; PG8_SCHED;
            PG8_LDB(B0, 1, 0); PG8_LDB(B1, 1, 1); PG8_SCHED; PG8_LDA(At, 1, 0); PG8_STAGE(PG8_SA(0, 1), a2 + hstep, voffA);
            PG8_WAIT_V(8); PG8_WAIT_L(0); PG8_BAR; PG8_MMA(0, 0, At, B0); PG8_MMA(0, 1, At, B1); PG8_BAR; PG8_SCHED;
            PG8_LDA(At, 1, 1); PG8_STAGE(PG8_SB(1, 0), b3, voffB); PG8_STAGE(PG8_SB(1, 1), b3 + hstep, voffB); PG8_STAGE(PG8_SA(1, 0), a3, voffA);
            PG8_WAIT_V(8); PG8_WAIT_L(0); PG8_BAR; PG8_MMA(1, 0, At, B0); PG8_MMA(1, 1, At, B1); PG8_BAR; PG8_SCHED;
            } else {
            PG8_LDB(B0, 0, 0); PG8_SCHED; PG8_LDA(At, 0, 0); PG8_STAGE(PG8_SA(1, 1), a1 + hstep, voffA);
            PG8_WAIT_L(8); PG8_BAR; PG8_WAIT_L(0); PG8_MMA(0, 0, At, B0); PG8_BAR; PG8_SCHED;
            PG8_LDB(B1, 0, 1); PG8_STAGE(PG8_SB(0, 0), b2, voffB);
            PG8_BAR; PG8_WAIT_L(0); PG8_MMA(0, 1, At, B1); PG8_BAR;
            PG8_LDA(At, 0, 1); PG8_STAGE(PG8_SA(0, 0), a2, voffA);
            PG8_BAR; PG8_WAIT_L(0); PG8_MMA(1, 0, At, B0); PG8_BAR; PG8_SCHED;
            PG8_STAGE(PG8_SB(0, 1), b2 + hstep, voffB);
            PG8_WAIT_V(6); PG8_BAR; PG8_MMA(1, 1, At, B1); PG8_BAR;
            PG8_LDB(B0, 1, 0); PG8_SCHED; PG8_LDA(At, 1, 0); PG8_STAGE(PG8_SA(0, 1), a2 + hstep, voffA);
            PG8_WAIT_L(8); PG8_BAR; PG8_WAIT_L(0); PG8_MMA(0, 0, At, B0); PG8_BAR; PG8_SCHED;
            PG8_LDB(B1, 1, 1); PG8_STAGE(PG8_SB(1, 0), b3, voffB);
            PG8_BAR; PG8_WAIT_L(0); PG8_MMA(0, 1, At, B1); PG8_BAR;
            PG8_LDA(At, 1, 1); PG8_STAGE(PG8_SA(1, 0), a3, voffA);
            PG8_BAR; PG8_WAIT_L(0); PG8_MMA(1, 0, At, B0); PG8_BAR; PG8_SCHED;
            PG8_STAGE(PG8_SB(1, 1), b3 + hstep, voffB);
            PG8_WAIT_V(6); PG8_BAR; PG8_MMA(1, 1, At, B1); PG8_BAR;
            }
        }
        if constexpr (ALIGN_EPI) { if (wr == 0) PG8_BAR; }
        if constexpr (!Epi::AFTER_DRAIN) { E(acc, cur, wr, wc, fr, fq); S.done(cur); }
        if (!has_next) break;
#pragma unroll
        for (int a = 0; a < 2; ++a)
#pragma unroll
            for (int b = 0; b < 2; ++b)
#pragma unroll
                for (int m = 0; m < 4; ++m)
#pragma unroll
                    for (int n = 0; n < 2; ++n) acc[a][b][m][n] = (f32x4){0.f, 0.f, 0.f, 0.f};
        cur = nxt; cA = nA; cB = nB; ++ui;
        if constexpr (ALIGN_EPI) { if (wr == 1) PG8_BAR; }
    }
    PG8_WAIT_V(0);
    if constexpr (!ALIGN_EPI) { if (wr == 0) PG8_BAR; }
    PG8_BAR;
    if constexpr (Epi::AFTER_DRAIN) { E.fused(acc, cur, wr, wc, fr, fq, lds, wid, lane); S.done(cur); }
#undef PG8_SA
#undef PG8_SB
#undef PG8_STAGE
#undef PG8_LDA
#undef PG8_LDB
#undef PG8_MMA
#undef PG8_WAIT_V
#undef PG8_WAIT_L
#undef PG8_BAR
#undef PG8_SCHED
}
}
#ifndef REP
#define REP 0
#endif
#ifndef MIXER_NAIVE
#define MIXER_NAIVE 0
#endif
#ifndef DIAG
#define DIAG 0
#endif
#ifndef SB_EARLY
#define SB_EARLY 0
#endif
#ifndef PG8_SP2
#define PG8_SP2 true
#endif
#ifndef PG8_ALIGN
#define PG8_ALIGN true
#endif
constexpr int NWAVES = 8;
constexpr int DM = 1024, NB = 16, SEQ = 2048, M = NB * SEQ, INC = 3584, DFF = 2816, NH = 8, HD = 64;
constexpr float EPS = 1e-6f;
constexpr float QSCALE = 0.125f * 1.4426950408889634f;
constexpr size_t MiB = 1u << 20;
constexpr size_t WS_CTL = 0, CTL_ZERO_BYTES = 64 * 1024;
constexpr size_t WS_WIN = 1 * MiB, WS_WOUT = 8 * MiB, WS_WGU = 10 * MiB, WS_WD = 21 * MiB;
constexpr size_t WS_SSQ2 = 27 * MiB;
constexpr size_t WS_T0 = 29 * MiB, WS_RSTD = 30 * MiB;
constexpr size_t WS_XB = 32 * MiB;
constexpr size_t WS_PROJ = 96 * MiB, SEG_ELEMS = (size_t)M * 512;
constexpr size_t WS_FF = 96 * MiB;
constexpr size_t WS_MIX = 320 * MiB;
constexpr size_t WS_X1 = 384 * MiB, WS_END = 512 * MiB;
constexpr int CW_BAR = 4096;
constexpr int RING_OFF = 0, RING_BYTES = 151552;
constexpr int LDSCTL_OFF = RING_BYTES, MISC_OFF = LDSCTL_OFF + 320;
constexpr int LDS_BYTES = 155648;
#define GAS __attribute__((address_space(1)))
#define LAS __attribute__((address_space(3)))
typedef unsigned short bf16;
typedef unsigned v4u __attribute__((ext_vector_type(4)));
typedef float f32x4 __attribute__((ext_vector_type(4)));
typedef short bf16x8 __attribute__((ext_vector_type(8)));
typedef GAS unsigned gu32;
typedef GAS unsigned long long gu64;
#define RLX_AGENT __ATOMIC_RELAXED, __HIP_MEMORY_SCOPE_AGENT
#define LDS_WAIT() asm volatile("s_waitcnt lgkmcnt(0)" ::: "memory")
#define VM_WAIT() asm volatile("s_waitcnt vmcnt(0)" ::: "memory")
__device__ __forceinline__ unsigned long long rt() { return __builtin_amdgcn_s_memrealtime(); }
__device__ __forceinline__ unsigned f2bf(float f) { unsigned u = __builtin_bit_cast(unsigned, f); return (u + 0x7fffu + ((u >> 16) & 1u)) >> 16; }
__device__ __forceinline__ unsigned pk2(float lo, float hi) { return f2bf(lo) | (f2bf(hi) << 16); }

#define XB_TMO      128
#define XB_XCNT(j)  (256  + 64 * (j))
#define XB_XSUB(j)  (1280 + 64 * (j))
#define XB_XGEN(j)  (2304 + 64 * (j))
#define XB_TOP      3328
#define XB_TOPGEN   3392
#define XCD_BAR_WORDS 3456
#define XB_SPIN_CAP (1u << 18)

__device__ __forceinline__ unsigned xb_ld(unsigned* p)              { return __hip_atomic_load(p, __ATOMIC_RELAXED, __HIP_MEMORY_SCOPE_AGENT); }
__device__ __forceinline__ unsigned xb_add(unsigned* p, unsigned v) { return __hip_atomic_fetch_add(p, v, __ATOMIC_RELAXED, __HIP_MEMORY_SCOPE_AGENT); }
__device__ __forceinline__ unsigned xb_xcc_id() { return (unsigned)__builtin_amdgcn_s_getreg((3 << 11) | 20) & 0xFu; }
#define XB_SPIN(cond, bar) do { unsigned _sp = 0; while (cond) { __builtin_amdgcn_s_sleep(1); \
    if ((++_sp & 255u) == 0u) { if (xb_ld(&(bar)[XB_TMO])) break; if (_sp > XB_SPIN_CAP) { atomicAdd(&(bar)[XB_TMO], 1u); break; } } } } while (0)

struct XcdBarrier {
    unsigned* bar; unsigned x;
    volatile LAS unsigned* st;
};

__device__ __forceinline__ XcdBarrier xcd_barrier_post(unsigned* bar, volatile LAS unsigned* st) {
    XcdBarrier b; b.bar = bar; b.x = xb_xcc_id(); b.st = st;
    if (threadIdx.x == 0) (void)xb_add(&bar[XB_XCNT(b.x)], 1u);
    return b;
}
__device__ __forceinline__ void xcd_barrier_complete(unsigned* bar, unsigned x, unsigned& nloc, unsigned& nx) {
    const unsigned G = gridDim.x * gridDim.y * gridDim.z;
    unsigned sum, cnt, mine, sp = 0u;
    for (;;) {
        sum = 0u; cnt = 0u; mine = 0u;
#pragma unroll
        for (unsigned j = 0; j < 16; ++j) { const unsigned c = xb_ld(&bar[XB_XCNT(j)]); sum += c; cnt += (c > 0u) ? 1u : 0u; mine = (j == x) ? c : mine; }
        if (sum == G) break;
        __builtin_amdgcn_s_sleep(1);
        if ((++sp & 255u) == 0u) { if (xb_ld(&bar[XB_TMO])) break; if (sp > XB_SPIN_CAP) { atomicAdd(&bar[XB_TMO], 1u); break; } }
    }
    nloc = mine > 0u ? mine : 1u; nx = cnt > 0u ? cnt : 1u;
}

__device__ __forceinline__ void xcd_barrier(const XcdBarrier& b) {
    asm volatile("s_waitcnt vmcnt(0)" ::: "memory");
    __syncthreads();
    if (threadIdx.x == 0) {
        unsigned* bar = b.bar;
        __builtin_amdgcn_s_waitcnt(0);
        unsigned nloc = b.st[0], nx = b.st[1];
        if (nloc == 0u) { xcd_barrier_complete(bar, b.x, nloc, nx); b.st[0] = nloc; b.st[1] = nx; }
        const unsigned old = xb_add(&bar[XB_XSUB(b.x)], 1u);
        const unsigned gen = old / nloc;
        if (old + 1u == (gen + 1u) * nloc) {
            __builtin_amdgcn_fence(__ATOMIC_RELEASE, "agent");
            asm volatile("s_waitcnt vmcnt(0)" ::: "memory");
            const unsigned og = xb_add(&bar[XB_TOP], 1u);
            const unsigned tg = og / nx;
            if (og + 1u == (tg + 1u) * nx) xb_add(&bar[XB_TOPGEN], 1u);
            else XB_SPIN(xb_ld(&bar[XB_TOPGEN]) == tg, bar);
            __builtin_amdgcn_fence(__ATOMIC_ACQUIRE, "agent");
            xb_add(&bar[XB_XGEN(b.x)], 1u);
            asm volatile("s_waitcnt vmcnt(0)" ::: "memory");
        } else {
            XB_SPIN(xb_ld(&bar[XB_XGEN(b.x)]) == gen, bar);
            __builtin_amdgcn_fence(__ATOMIC_ACQUIRE, "agent");
            asm volatile("s_waitcnt vmcnt(0)" ::: "memory");
        }
    }
    __syncthreads();
}
struct Args { const float* in[12]; float* out; unsigned char* ws; };
__device__ __forceinline__ float wave_sum(float v) {
#pragma unroll
    for (int o = 1; o < 64; o <<= 1) v += __shfl_xor(v, o);
    return v;
}
__device__ __forceinline__ float bf2f(unsigned short b) { return __builtin_bit_cast(float, (unsigned)b << 16); }

__device__ __forceinline__ void p0_transpose_item(const float* W, int K, int N, bf16* WT, int drow0, const float* gk, LAS float* scr, int k0, int n0, int lane) {
#pragma unroll 8
    for (int i = 0; i < 32; ++i) { const int kk = 2 * i + (lane >> 5); float v = W[(size_t)(k0 + kk) * N + n0 + (lane & 31)]; if (gk) v *= gk[k0 + kk]; scr[kk * 33 + (lane & 31)] = v; }
    LDS_WAIT(); asm volatile("" ::: "memory");
    const int c = lane & 7;
#pragma unroll
    for (int j = 0; j < 4; ++j) { const int n = (lane >> 3) + 8 * j; const LAS float* s = scr + (8 * c) * 33 + n;
        v4u o; o.x = pk2(s[0 * 33], s[1 * 33]); o.y = pk2(s[2 * 33], s[3 * 33]); o.z = pk2(s[4 * 33], s[5 * 33]); o.w = pk2(s[6 * 33], s[7 * 33]);
        *(GAS v4u*)(WT + (size_t)(drow0 + n) * K + k0 + 8 * c) = o; }
    LDS_WAIT(); asm volatile("" ::: "memory");
}
__device__ __forceinline__ void rms_row_to_bf16(const float* xrow, bf16* orow, float* rstd_out, int lane) {
    const GAS f32x4* xr = (const GAS f32x4*)xrow + lane;
    f32x4 v[4]; float s = 0.f;
#pragma unroll
    for (int j = 0; j < 4; ++j) { v[j] = xr[64 * j]; s += (v[j].x * v[j].x + v[j].y * v[j].y) + (v[j].z * v[j].z + v[j].w * v[j].w); }
    const float rstd = rsqrtf(wave_sum(s) * (1.f / DM) + EPS);
    if (lane == 0) *rstd_out = rstd;
    GAS unsigned long long* o8 = (GAS unsigned long long*)orow + lane;
#pragma unroll
    for (int j = 0; j < 4; ++j) o8[64 * j] = (unsigned long long)pk2(v[j].x * rstd, v[j].y * rstd) | ((unsigned long long)pk2(v[j].z * rstd, v[j].w * rstd) << 32);
}
__device__ __forceinline__ void rms_row_inplace(float* xrow, const float* g, int lane) {
    GAS f32x4* xr = (GAS f32x4*)xrow + lane;
    f32x4 v[4]; float s = 0.f;
#pragma unroll
    for (int j = 0; j < 4; ++j) { v[j] = xr[64 * j]; s += (v[j].x * v[j].x + v[j].y * v[j].y) + (v[j].z * v[j].z + v[j].w * v[j].w); }
    const float rstd = rsqrtf(wave_sum(s) * (1.f / DM) + EPS);
#pragma unroll
    for (int j = 0; j < 4; ++j) { const f32x4 gv = ((const GAS f32x4*)g)[lane + 64 * j]; xr[64 * j] = v[j] * rstd * gv; }
}

__device__ __forceinline__ void p0_token0_item(int item, const float* x, const float* mix_g, const float* w_in, float* T0, int lane) {
    const int cg = item & 15, b = (item >> 4) & 15, ks = item >> 8;
    const float* xr = x + (size_t)b * SEQ * DM + ks * 128; const float* gr = mix_g + ks * 128;
    const float xa = xr[lane] * gr[lane], xb2 = xr[64 + lane] * gr[64 + lane];
    const float* wp = w_in + (size_t)(ks * 128) * INC + cg * 64 + lane;
    float a0 = 0.f, a1 = 0.f, a2 = 0.f, a3 = 0.f;
#pragma unroll 4
    for (int kk = 0; kk < 64; kk += 4) {
        const float w0 = wp[(size_t)(kk + 0) * INC], w1 = wp[(size_t)(kk + 1) * INC], w2 = wp[(size_t)(kk + 2) * INC], w3 = wp[(size_t)(kk + 3) * INC];
        const float w4 = wp[(size_t)(64 + kk + 0) * INC], w5 = wp[(size_t)(64 + kk + 1) * INC], w6 = wp[(size_t)(64 + kk + 2) * INC], w7 = wp[(size_t)(64 + kk + 3) * INC];
        a0 = fmaf(__shfl(xa, kk + 0), w0, a0); a1 = fmaf(__shfl(xa, kk + 1), w1, a1); a2 = fmaf(__shfl(xa, kk + 2), w2, a2); a3 = fmaf(__shfl(xa, kk + 3), w3, a3);
        a0 = fmaf(__shfl(xb2, kk + 0), w4, a0); a1 = fmaf(__shfl(xb2, kk + 1), w5, a1); a2 = fmaf(__shfl(xb2, kk + 2), w6, a2); a3 = fmaf(__shfl(xb2, kk + 3), w7, a3);
    }
    T0[((size_t)ks * 16 + b) * 1024 + cg * 64 + lane] = (a0 + a1) + (a2 + a3);
}
__device__ __forceinline__ float sigmoid_f(float x) { return 1.0f / (1.0f + __expf(-x)); }
__device__ __forceinline__ void hgrn_naive_task(int bh, const bf16* HQ, const bf16* HF, const bf16* HI, const bf16* HGt, const float* lbnd, const float* ng, bf16* mixed, LAS unsigned char* lds, int tid, const float* x, const float* mix_g, const float* w_in) {
    constexpr int TS = 8;
    LAS float* st = (LAS float*)lds;
    LAS float* part = st + 4 * TS * 64;
    const int b = bh >> 3, h = bh & 7, e = tid & 63, dg = tid >> 6;
    float lb[8], S[8];
#pragma unroll
    for (int i = 0; i < 8; ++i) { const int d = h * 64 + dg * 8 + i; const float l0 = lbnd[d], l1 = lbnd[512 + d]; lb[i] = 1.0f / (1.0f + __expf(l1 - l0)); S[i] = 0.f; }
    const float g = ng[h * 64 + e];
    LAS float* hp = part + TS * 8 * 64;
    { const float* xr = x + (size_t)(b * SEQ) * DM; const int lane = tid & 63;
      const float v0 = xr[tid], v1 = xr[tid + 512]; float s = wave_sum(v0 * v0 + v1 * v1);
      LAS float* red = hp + 128; if (lane == 0) red[dg] = s; __syncthreads();
      float tot = 0.f; for (int w = 0; w < 8; ++w) tot += red[w]; const float rstd = rsqrtf(tot * (1.0f / DM) + EPS);
      const int c = tid & 127, kp = tid >> 7; const int col = (c < 64) ? (h * 64 + c) : (512 + h * 64 + (c - 64));
      float acc = 0.f; for (int k = kp * 256; k < kp * 256 + 256; ++k) acc = fmaf(xr[k] * mix_g[k], w_in[(size_t)k * INC + col], acc);
      acc *= rstd; LAS float* pr = hp + 144; pr[kp * 128 + c] = acc; __syncthreads();
      if (tid < 128) hp[tid] = (pr[tid] + pr[128 + tid]) + (pr[256 + tid] + pr[384 + tid]);
      __syncthreads(); }
    for (int t0 = 0; t0 < SEQ; t0 += TS) {
        __syncthreads();
        { const size_t off = (size_t)(b * SEQ + t0 + dg) * 512 + h * 64 + e;
          st[(0 * TS + dg) * 64 + e] = bf2f(HQ[off]); st[(1 * TS + dg) * 64 + e] = bf2f(HF[off]); st[(2 * TS + dg) * 64 + e] = bf2f(HI[off]); st[(3 * TS + dg) * 64 + e] = bf2f(HGt[off]);
          if (t0 == 0 && dg == 0) { st[e] = hp[e]; st[(1 * TS) * 64 + e] = hp[64 + e]; } }
        __syncthreads();
#pragma unroll
        for (int s = 0; s < TS; ++s) { const float ve = st[(2 * TS + s) * 64 + e]; float po = 0.f;
#pragma unroll
            for (int i = 0; i < 8; ++i) { const float fl = st[(1 * TS + s) * 64 + dg * 8 + i], q = st[(0 * TS + s) * 64 + dg * 8 + i];
                const float f = lb[i] + (1.0f - lb[i]) * sigmoid_f(fl); S[i] = f * S[i] + (1.0f - f) * ve; po = fmaf(S[i], q, po); }
            part[(s * 8 + dg) * 64 + e] = po; }
        __syncthreads();
        { const int s = dg; float o = 0.f;
#pragma unroll
          for (int gq = 0; gq < 8; ++gq) o += part[(s * 8 + gq) * 64 + e];
          const float ms = wave_sum(o * o) * (1.0f / 64.0f); const float gt = st[(3 * TS + s) * 64 + e];
          const float y = o * rsqrtf(ms + EPS) * g * (gt * sigmoid_f(gt));
          mixed[(size_t)(b * SEQ + t0 + s) * DM + h * 64 + e] = (bf16)f2bf(y); }
    }
    __syncthreads();
}
__device__ __forceinline__ void sb_naive_task(int bh, int qb, const bf16* SQ, const bf16* SK, const bf16* SV, const float* ng, bf16* mixed, LAS unsigned char* wl, int lane) {
    LAS unsigned short* Ks = (LAS unsigned short*)wl;
    LAS unsigned short* Vs = Ks + 4096;
    const int b = bh >> 3, h = bh & 7, tq = qb * 64 + lane;
    float q[64], o[64];
    { const GAS v4u* qp = (const GAS v4u*)(SQ + (size_t)(b * SEQ + tq) * 512 + h * 64);
#pragma unroll
      for (int c = 0; c < 8; ++c) { const v4u w = qp[c];
#pragma unroll
          for (int i = 0; i < 4; ++i) { q[c * 8 + 2 * i] = __builtin_bit_cast(float, w[i] << 16); q[c * 8 + 2 * i + 1] = __builtin_bit_cast(float, w[i] & 0xffff0000u); } }
#pragma unroll
      for (int d = 0; d < 64; ++d) o[d] = 0.f; }
    float A = 0.f;
    for (int kt = qb; kt >= 0; --kt) {
        asm volatile("s_waitcnt lgkmcnt(0)" ::: "memory");
#pragma unroll
        for (int j = 0; j < 8; ++j) { const int c = lane + 64 * j, row = c >> 3, ch = c & 7; const size_t off = (size_t)(b * SEQ + kt * 64 + row) * 512 + h * 64 + ch * 8;
            *(LAS v4u*)(Ks + row * 64 + ch * 8) = *(const GAS v4u*)(SK + off); *(LAS v4u*)(Vs + row * 64 + ch * 8) = *(const GAS v4u*)(SV + off); }
        asm volatile("s_waitcnt lgkmcnt(0)" ::: "memory");
        for (int j = 63; j >= 0; --j) {
            const int s = kt * 64 + j; float z = 0.f;
#pragma unroll
            for (int c = 0; c < 8; ++c) { const v4u w = *(const LAS v4u*)(Ks + j * 64 + c * 8);
#pragma unroll
                for (int i = 0; i < 4; ++i) { z = fmaf(q[c * 8 + 2 * i], __builtin_bit_cast(float, w[i] << 16), z); z = fmaf(q[c * 8 + 2 * i + 1], __builtin_bit_cast(float, w[i] & 0xffff0000u), z); } }
            const bool act = s < tq;
            const float c2 = act ? (fmaxf(z, 0.f) + __builtin_amdgcn_logf(1.0f + __builtin_amdgcn_exp2f(-fabsf(z)))) : 0.f;
            const float w2 = act ? __builtin_amdgcn_exp2f(z - c2 - A) : 0.f;
            A += c2;
#pragma unroll
            for (int c = 0; c < 8; ++c) { const v4u w = *(const LAS v4u*)(Vs + j * 64 + c * 8);
#pragma unroll
                for (int i = 0; i < 4; ++i) { o[c * 8 + 2 * i] = fmaf(w2, __builtin_bit_cast(float, w[i] << 16), o[c * 8 + 2 * i]); o[c * 8 + 2 * i + 1] = fmaf(w2, __builtin_bit_cast(float, w[i] & 0xffff0000u), o[c * 8 + 2 * i + 1]); } }
        }
    }
    float ss = 0.f;
#pragma unroll
    for (int d = 0; d < 64; ++d) ss = fmaf(o[d], o[d], ss);
    const float r = rsqrtf(ss * (1.0f / 64.0f) + EPS);
    GAS v4u* op = (GAS v4u*)(mixed + (size_t)(b * SEQ + tq) * DM + 512 + h * 64);
#pragma unroll
    for (int c = 0; c < 8; ++c) { v4u w;
#pragma unroll
        for (int i = 0; i < 4; ++i) { const int d = c * 8 + 2 * i; w[i] = pk2(o[d] * r * ng[h * 64 + d], o[d + 1] * r * ng[h * 64 + d + 1]); }
        op[c] = w; }
}
namespace sbk {
typedef short bf16x8 __attribute__((ext_vector_type(8)));
typedef short s16x4 __attribute__((ext_vector_type(4)));
typedef float f32x16 __attribute__((ext_vector_type(16)));
typedef unsigned u32x4 __attribute__((ext_vector_type(4)));
typedef short v4i16_t __attribute__((ext_vector_type(4)));
constexpr int NSLOT = 3, SLOTB = 8192, PFD = NSLOT - 1;
constexpr int LDS_K = 0, LDS_V = NSLOT * SLOTB, LDS_OST = 0, OSTW = 32 * 68 * 4, LDS_FLAG = 8 * OSTW, LDS_TOTAL = LDS_FLAG + 256;
__device__ __forceinline__ int crow(int r, int hi) { return (r & 3) + 8 * (r >> 2) + 4 * hi; }
__device__ __forceinline__ void glds16(const void* gsrc, unsigned lds_dst) { unsigned keep;
    asm volatile("s_mov_b32 %0, m0\n\ts_mov_b32 m0, %2\n\ts_nop 0\n\tglobal_load_lds_dwordx4 %1, off\n\ts_mov_b32 m0, %0" : "=&s"(keep) : "v"(gsrc), "s"(lds_dst) : "memory"); }
typedef float f32x2_t __attribute__((ext_vector_type(2))); typedef __bf16 bf16x2_t __attribute__((ext_vector_type(2)));
__device__ __forceinline__ unsigned cvtpk(float lo, float hi) { f32x2_t v = {lo, hi}; bf16x2_t b = __builtin_convertvector(v, bf16x2_t); return __builtin_bit_cast(unsigned, b); }
__device__ __forceinline__ s16x4 vtr(const LAS unsigned char* p) { return __builtin_bit_cast(s16x4, __builtin_amdgcn_ds_read_tr16_b64_v4i16((LAS v4i16_t*)p)); }
__device__ __forceinline__ float xchg32(float v, int hi) {
    auto rr = __builtin_amdgcn_permlane32_swap(__float_as_uint(v), __float_as_uint(v), false, false);
    return __uint_as_float(hi ? rr[0] : rr[1]); }
#define SB_WAIT_BAR(N) asm volatile("s_waitcnt vmcnt(" #N ") lgkmcnt(0)\n\ts_barrier" ::: "memory")

#define SB_QUAD(P, B, KV0, T) do { float r_[4], be_[4]; \
    _Pragma("unroll") for (int i_ = 0; i_ < 4; ++i_) { const float u_ = __builtin_amdgcn_exp2f(P[(B) + i_]); const float rr_ = __builtin_amdgcn_rcpf(1.0f + u_); float b_ = 1.0f - rr_; float r1_ = rr_;     \
        if (BAND) { const bool m_ = ((KV0) + i_) >= qrel; r1_ = m_ ? 1.0f : r1_; b_ = m_ ? 0.0f : b_; } r_[i_] = r1_; be_[i_] = b_; } \
    const float s2_ = r_[3], s1_ = s2_ * r_[2], s0_ = s1_ * r_[1]; T = s0_ * r_[0]; \
    P[(B) + 3] = be_[3]; P[(B) + 2] = be_[2] * s2_; P[(B) + 1] = be_[1] * s1_; P[(B)] = be_[0] * s0_; } while (0)

template <bool BAND> __device__ __forceinline__ void sb_tile(f32x16& o0, f32x16& o1, float& Pacc, const bf16x8 (&qr)[4], const LAS unsigned char* Ks, const LAS unsigned char* Vs, int jb, int qrel, int lane) {
    const int r32 = lane & 31, hi = lane >> 5;
    f32x16 p0, p1;
    { const LAS unsigned char* kb = Ks + hi * 1024 + r32 * 16; const f32x16 z = {};
#pragma unroll
      for (int d0 = 0; d0 < 4; ++d0) { const bf16x8 b0 = *(const LAS bf16x8*)(kb + d0 * 2048); const bf16x8 b1 = *(const LAS bf16x8*)(kb + d0 * 2048 + 512);
          p0 = __builtin_amdgcn_mfma_f32_32x32x16_bf16(b0, qr[d0], d0 == 0 ? z : p0, 0, 0, 0); p1 = __builtin_amdgcn_mfma_f32_32x32x16_bf16(b1, qr[d0], d0 == 0 ? z : p1, 0, 0, 0); } }
    float T[8]; const int kvb = 64 * jb + 4 * hi;
    SB_QUAD(p1, 12, kvb + 32 + 24, T[0]); SB_QUAD(p1, 8, kvb + 32 + 16, T[1]); SB_QUAD(p1, 4, kvb + 32 + 8, T[2]); SB_QUAD(p1, 0, kvb + 32, T[3]);
    SB_QUAD(p0, 12, kvb + 24, T[4]); SB_QUAD(p0, 8, kvb + 16, T[5]); SB_QUAD(p0, 4, kvb + 8, T[6]); SB_QUAD(p0, 0, kvb, T[7]);
    float OE[8], OI[8]; OE[0] = 1.0f;
#pragma unroll
    for (int i = 0; i < 8; ++i) { OI[i] = OE[i] * T[i]; if (i < 7) OE[i + 1] = OI[i]; }
    float Off[8];
#pragma unroll
    for (int i = 0; i < 8; ++i) { const float X = xchg32(hi ? OI[i] : OE[i], hi); Off[i] = Pacc * OE[i] * X; if (i == 7) { const float cand = Pacc * OI[7] * X; const float pc = xchg32(cand, hi); Pacc = hi ? pc : cand; } }
#pragma unroll
    for (int i = 0; i < 4; ++i) { p1[12 + i] *= Off[0]; p1[8 + i] *= Off[1]; p1[4 + i] *= Off[2]; p1[i] *= Off[3]; p0[12 + i] *= Off[4]; p0[8 + i] *= Off[5]; p0[4 + i] *= Off[6]; p0[i] *= Off[7]; }
    u32x4 pw0, pw1, pw2, pw3;
#pragma unroll
    for (int i = 0; i < 4; ++i) { pw0[i] = cvtpk(p0[2 * i], p0[2 * i + 1]); pw1[i] = cvtpk(p0[8 + 2 * i], p0[8 + 2 * i + 1]); pw2[i] = cvtpk(p1[2 * i], p1[2 * i + 1]); pw3[i] = cvtpk(p1[8 + 2 * i], p1[8 + 2 * i + 1]); }
    const LAS unsigned char* vp = Vs + ((lane >> 4) & 1) * 32 + (lane & 3) * 8 + (4 * hi + ((lane & 15) >> 2)) * 64;
#define SB_VFR(i) ({ const s16x4 lo_ = vtr(vp + ((i) >> 2) * 4096 + ((i) & 3) * 1024), hi_ = vtr(vp + ((i) >> 2) * 4096 + ((i) & 3) * 1024 + 512); (bf16x8){lo_[0], lo_[1], lo_[2], lo_[3], hi_[0], hi_[1], hi_[2], hi_[3]}; })
    o0 = __builtin_amdgcn_mfma_f32_32x32x16_bf16(__builtin_bit_cast(bf16x8, pw0), SB_VFR(0), o0, 0, 0, 0); o1 = __builtin_amdgcn_mfma_f32_32x32x16_bf16(__builtin_bit_cast(bf16x8, pw0), SB_VFR(4), o1, 0, 0, 0);
    o0 = __builtin_amdgcn_mfma_f32_32x32x16_bf16(__builtin_bit_cast(bf16x8, pw1), SB_VFR(1), o0, 0, 0, 0); o1 = __builtin_amdgcn_mfma_f32_32x32x16_bf16(__builtin_bit_cast(bf16x8, pw1), SB_VFR(5), o1, 0, 0, 0);
    o0 = __builtin_amdgcn_mfma_f32_32x32x16_bf16(__builtin_bit_cast(bf16x8, pw2), SB_VFR(2), o0, 0, 0, 0); o1 = __builtin_amdgcn_mfma_f32_32x32x16_bf16(__builtin_bit_cast(bf16x8, pw2), SB_VFR(6), o1, 0, 0, 0);
    o0 = __builtin_amdgcn_mfma_f32_32x32x16_bf16(__builtin_bit_cast(bf16x8, pw3), SB_VFR(3), o0, 0, 0, 0); o1 = __builtin_amdgcn_mfma_f32_32x32x16_bf16(__builtin_bit_cast(bf16x8, pw3), SB_VFR(7), o1, 0, 0, 0);
#undef SB_VFR
}

template <bool EARLY> __device__ __forceinline__ void sb_unit(int bh, int qb, const bf16* SQ, const bf16* SK, const bf16* SV, const float* ng, bf16* MIXo, LAS unsigned char* shm) {
    const int tid = threadIdx.x, lane = tid & 63, r32 = lane & 31, hi = lane >> 5; const int wid = __builtin_amdgcn_readfirstlane(tid >> 6);
    const int b = bh >> 3, h = bh & 7; const long rowbase = (long)b * SEQ; const int q0 = qb * 256;
    const unsigned lds0 = (unsigned)(size_t)shm;
    const bf16* ksrc = SK + (rowbase + lane) * 512 + h * 64 + wid * 8;
    const bf16* vsrc = SV + (rowbase + 16 * (wid & 3) + (lane >> 2)) * 512 + h * 64 + (wid >> 2) * 32 + (lane & 3) * 8;
    const unsigned kdst = lds0 + LDS_K + wid * 1024, vdst = lds0 + LDS_V + wid * 1024;
#define SB_DMA(t, slot) do { glds16(ksrc + (long)(t) * 64 * 512, (unsigned)__builtin_amdgcn_readfirstlane(kdst + (slot))); glds16(vsrc + (long)(t) * 64 * 512, (unsigned)__builtin_amdgcn_readfirstlane(vdst + (slot))); } while (0)
    const int rb = ((wid & 3) << 1) | (wid >> 2);
    const int NT = 4 * qb + 4, t_top = 4 * qb + (rb >> 1), qrel = rb * 32 + r32;
#pragma unroll
    for (int j = 0; j < PFD; ++j) if (j < NT) SB_DMA(NT - 1 - j, j * SLOTB);
    bf16x8 qr[4];
    { const bf16* Qw = SQ + (rowbase + q0 + rb * 32 + r32) * 512 + h * 64 + hi * 8;
#pragma unroll
      for (int d0 = 0; d0 < 4; ++d0) qr[d0] = *(const GAS bf16x8*)(Qw + d0 * 16); }
    f32x16 o0 = {}, o1 = {}; float Pacc = 1.0f; bool walive = true;
    volatile LAS unsigned* flag = (volatile LAS unsigned*)(shm + LDS_FLAG);
    int sl_cur = 0, sl_pf = PFD * SLOTB;
    for (int it = 0; it < NT; ++it) {
        const int t = NT - 1 - it;
        if (t >= PFD - 1) { SB_WAIT_BAR(2); } else { SB_WAIT_BAR(0); }
        if (t >= PFD) SB_DMA(t - PFD, sl_pf);
        if (EARLY && it > 0) { unsigned any = 0u;
#pragma unroll
            for (int w = 0; w < 8; ++w) any |= flag[((it - 1) & 1) * 8 + w];
            if (any == 0u) break; }
        if (t <= t_top && (!EARLY || walive)) {
            const LAS unsigned char* Ks = shm + LDS_K + sl_cur; const LAS unsigned char* Vs = shm + LDS_V + sl_cur;
            if (t >= 4 * qb) sb_tile<true>(o0, o1, Pacc, qr, Ks, Vs, t - 4 * qb, qrel, lane);
            else sb_tile<false>(o0, o1, Pacc, qr, Ks, Vs, 0, qrel, lane);
        }
        if (EARLY) { walive = __any(Pacc != 0.0f) != 0; if (lane == 0) flag[(it & 1) * 8 + wid] = walive ? 1u : 0u; }
        sl_pf = sl_cur; sl_cur = (sl_cur == (NSLOT - 1) * SLOTB) ? 0 : sl_cur + SLOTB;
    }
    asm volatile("s_waitcnt vmcnt(0) lgkmcnt(0)\n\ts_barrier" ::: "memory");
    { LAS float* stg = (LAS float*)(shm + LDS_OST + wid * OSTW);
#pragma unroll
      for (int r = 0; r < 16; ++r) { const int orow = crow(r, hi); stg[orow * 68 + r32] = o0[r]; stg[orow * 68 + 32 + r32] = o1[r]; }
      asm volatile("s_waitcnt lgkmcnt(0)" ::: "memory");
      const int row = lane >> 1, half = lane & 1; f32x4 v[8]; float ss = 0.f;
#pragma unroll
      for (int i = 0; i < 8; ++i) { v[i] = *(const LAS f32x4*)(stg + row * 68 + half * 32 + 4 * i); ss += (v[i].x * v[i].x + v[i].y * v[i].y) + (v[i].z * v[i].z + v[i].w * v[i].w); }
      ss += __shfl_xor(ss, 1);
      const float rs = rsqrtf(ss * (1.0f / 64.0f) + EPS);
      const float* gp = ng + h * 64 + half * 32; bf16* op = MIXo + (rowbase + q0 + rb * 32 + row) * DM + 512 + h * 64 + half * 32;
#pragma unroll
      for (int i = 0; i < 4; ++i) { const f32x4 g0 = *(const GAS f32x4*)(gp + 8 * i), g1 = *(const GAS f32x4*)(gp + 8 * i + 4); const f32x4 a = v[2 * i] * rs * g0, c = v[2 * i + 1] * rs * g1;
          u32x4 w; w.x = cvtpk(a.x, a.y); w.y = cvtpk(a.z, a.w); w.z = cvtpk(c.x, c.y); w.w = cvtpk(c.z, c.w); *(GAS u32x4*)(op + 8 * i) = w; } }
    asm volatile("s_waitcnt vmcnt(0) lgkmcnt(0)\n\ts_barrier" ::: "memory");
#undef SB_DMA
}
#undef SB_QUAD
#undef SB_WAIT_BAR
}
namespace hg {
typedef short bf16x8 __attribute__((ext_vector_type(8)));
typedef short s16x4 __attribute__((ext_vector_type(4)));
typedef unsigned u32x4 __attribute__((ext_vector_type(4)));
typedef unsigned u32x2 __attribute__((ext_vector_type(2)));
typedef short v4i16_t __attribute__((ext_vector_type(4)));
constexpr int NBUF = 3, IN0 = 0, IMG_QE = NBUF * 32768, IMG_KE = IMG_QE + 8192, IMG_P = IMG_KE + 8192, O_ST = IMG_P + 8192, DEC = O_ST + 64 * 68 * 4, HP = DEC + 256, LDS_TOTAL = HP + 1024;
__device__ __forceinline__ void glds16(const void* gsrc, unsigned lds_dst) { unsigned keep;
    asm volatile("s_mov_b32 %0, m0\n\ts_mov_b32 m0, %2\n\ts_nop 0\n\tglobal_load_lds_dwordx4 %1, off\n\ts_mov_b32 m0, %0" : "=&s"(keep) : "v"(gsrc), "s"(lds_dst) : "memory"); }
#ifndef HG_DPP
#define HG_DPP 1
#endif
#define dpp_f(idv, v, ctrl, rmask) __builtin_bit_cast(float, __builtin_amdgcn_update_dpp(__builtin_bit_cast(int, (float)(idv)), __builtin_bit_cast(int, (float)(v)), (ctrl), (rmask), 0xf, false))
#define HG_BAR_L() asm volatile("s_waitcnt lgkmcnt(0)\n\ts_barrier" ::: "memory")
#define HG_BAR_VL() asm volatile("s_waitcnt vmcnt(0) lgkmcnt(0)\n\ts_barrier" ::: "memory")
#define HG_BAR_V4L() asm volatile("s_waitcnt vmcnt(4) lgkmcnt(0)\n\ts_barrier" ::: "memory")
__device__ __forceinline__ int img_off(int row, int col) { return row * 128 + ((((col >> 3) ^ row) & 7) << 4) + (col & 7) * 2; }
__device__ __forceinline__ s16x4 vtr(const LAS unsigned char* p) { return __builtin_bit_cast(s16x4, __builtin_amdgcn_ds_read_tr16_b64_v4i16((LAS v4i16_t*)p)); }
__device__ __forceinline__ unsigned cvtpk(float lo, float hi) { typedef float f2 __attribute__((ext_vector_type(2))); typedef __bf16 b2 __attribute__((ext_vector_type(2))); f2 v = {lo, hi}; b2 b = __builtin_convertvector(v, b2); return __builtin_bit_cast(unsigned, b); }
__device__ __forceinline__ float blo(unsigned w) { return __builtin_bit_cast(float, w << 16); }
__device__ __forceinline__ float bhi(unsigned w) { return __builtin_bit_cast(float, w & 0xffff0000u); }

__device__ __forceinline__ void hgrn_task(int bh, const bf16* HQ, const bf16* HF, const bf16* HI, const bf16* HGt, const float* lbnd, const float* ng, bf16* MIXo, LAS unsigned char* shm,
                                          const float* T0, const float* RSTD1) {
    const int tid = threadIdx.x, lane = tid & 63; const int w = __builtin_amdgcn_readfirstlane(tid >> 6);
    const int b = bh >> 3, h = bh & 7; const long rowbase = (long)b * SEQ;
    const int c16 = lane & 15, g4 = lane >> 4, tq = (lane & 15) >> 2, tp = lane & 3;
    LAS float* ost = (LAS float*)(shm + O_ST); LAS float* decs = (LAS float*)(shm + DEC); LAS float* hp = (LAS float*)(shm + HP);
    for (int u = tid; u < 8192 / 16; u += 512) *(LAS u32x4*)(shm + IMG_P + u * 16) = (u32x4){0u, 0u, 0u, 0u};
    float lb[8];
#pragma unroll
    for (int i = 0; i < 8; ++i) { const int d = h * 64 + 8 * w + i; const float l0 = lbnd[d], l1 = lbnd[512 + d]; lb[i] = 1.0f / (1.0f + __expf(l1 - l0)); }
    if (w == 0) {
        const float rstd = RSTD1[rowbase]; float q0 = 0.f, fl0 = 0.f;
#pragma unroll
        for (int ks = 0; ks < 8; ++ks) { q0 += T0[((size_t)ks * 16 + b) * 1024 + h * 64 + lane]; fl0 += T0[((size_t)ks * 16 + b) * 1024 + 512 + h * 64 + lane]; }
        q0 *= rstd; fl0 *= rstd;
        const int d = h * 64 + lane; const float l0 = lbnd[d], l1 = lbnd[512 + d]; const float lbd = 1.0f / (1.0f + __expf(l1 - l0));
        const float f0 = lbd + (1.0f - lbd) / (1.0f + __expf(-fl0)); const float al = wave_sum((1.0f - f0) * q0); if (lane == 0) hp[136] = al; }
    f32x4 S[4];
#pragma unroll
    for (int i = 0; i < 4; ++i) S[i] = (f32x4){0.f, 0.f, 0.f, 0.f};
    const int drow = 8 * w + (lane >> 3), dchk = (lane & 7) ^ ((lane >> 3) & 7);
    const size_t src_off = (size_t)(rowbase + drow) * 512 + h * 64 + dchk * 8;
    const unsigned lds0 = (unsigned)(size_t)shm;
#define HG_DMA(n_, buf_) do { const size_t so_ = src_off + (size_t)(n_) * 64 * 512; const unsigned ld_ = lds0 + IN0 + (buf_) * 32768 + w * 1024; \
        glds16(HF + so_, (unsigned)__builtin_amdgcn_readfirstlane(ld_)); glds16(HQ + so_, (unsigned)__builtin_amdgcn_readfirstlane(ld_ + 8192)); \
        glds16(HI + so_, (unsigned)__builtin_amdgcn_readfirstlane(ld_ + 16384)); glds16(HGt + so_, (unsigned)__builtin_amdgcn_readfirstlane(ld_ + 24576)); } while (0)
    const int erow = 8 * w + (lane >> 3), ec = (lane & 7) * 8;
    const f32x4 gn0 = *(const GAS f32x4*)(ng + h * 64 + ec), gn1 = *(const GAS f32x4*)(ng + h * 64 + ec + 4);
    HG_DMA(0, 0); HG_DMA(1, 1);
    HG_BAR_V4L();
    int bcur = 0, bpf = 2;
    for (int n = 0; n < SEQ / 64; ++n) {
        const LAS unsigned char* inb = shm + IN0 + bcur * 32768;
        { const u32x4 nfl = *(const LAS u32x4*)(inb + img_off(lane, 8 * w)), nq = *(const LAS u32x4*)(inb + 8192 + img_off(lane, 8 * w));
          float E[8], kk[8], qv[8];
#pragma unroll
          for (int i = 0; i < 4; ++i) { const float fa = blo(nfl[i]), fb = bhi(nfl[i]);
              const float f0 = lb[2 * i] + (1.0f - lb[2 * i]) * __builtin_amdgcn_rcpf(1.0f + __builtin_amdgcn_exp2f(-1.4426950408889634f * fa));
              const float f1 = lb[2 * i + 1] + (1.0f - lb[2 * i + 1]) * __builtin_amdgcn_rcpf(1.0f + __builtin_amdgcn_exp2f(-1.4426950408889634f * fb));
              E[2 * i] = f0; E[2 * i + 1] = f1; kk[2 * i] = 1.0f - f0; kk[2 * i + 1] = 1.0f - f1; qv[2 * i] = blo(nq[i]); qv[2 * i + 1] = bhi(nq[i]); }
#if HG_DPP
#pragma unroll
          for (int i = 0; i < 8; ++i) { float v = E[i];
              v *= dpp_f(1.0f, v, 0x111, 0xf); v *= dpp_f(1.0f, v, 0x112, 0xf); v *= dpp_f(1.0f, v, 0x114, 0xf); v *= dpp_f(1.0f, v, 0x118, 0xf);
              v *= dpp_f(1.0f, v, 0x142, 0xa);
              v *= dpp_f(1.0f, v, 0x143, 0xc);
              E[i] = v; }
#else
#pragma unroll
          for (int off = 1; off < 64; off <<= 1) {
#pragma unroll
              for (int i = 0; i < 8; ++i) { const float t_ = __shfl_up(E[i], off); if (lane >= off) E[i] *= t_; } }
#endif
          if (lane == 63) { *(LAS f32x4*)(decs + 8 * w) = (f32x4){E[0], E[1], E[2], E[3]}; *(LAS f32x4*)(decs + 8 * w + 4) = (f32x4){E[4], E[5], E[6], E[7]}; }
          u32x4 qe, ke;
#pragma unroll
          for (int i = 0; i < 4; ++i) { const float i0 = __builtin_amdgcn_rcpf(E[2 * i]), i1 = __builtin_amdgcn_rcpf(E[2 * i + 1]);
              qe[i] = cvtpk(qv[2 * i] * E[2 * i], qv[2 * i + 1] * E[2 * i + 1]); ke[i] = cvtpk(kk[2 * i] * i0, kk[2 * i + 1] * i1); }
          const int io = img_off(lane, 8 * w);
          *(LAS u32x4*)(shm + IMG_QE + io) = qe; *(LAS u32x4*)(shm + IMG_KE + io) = ke; }
        HG_BAR_L();
        if (n + 2 < SEQ / 64) HG_DMA(n + 2, bpf);
#pragma unroll
        for (int rep = 0; rep < 2; ++rep) { const int idx = w + 8 * rep;
            if (idx < 10) { const int ib = idx < 1 ? 0 : idx < 3 ? 1 : idx < 6 ? 2 : 3; const int jb = idx - (ib * (ib + 1)) / 2;
                f32x4 acc = {0.f, 0.f, 0.f, 0.f};
#pragma unroll
                for (int ks = 0; ks < 2; ++ks) { const bf16x8 a = *(const LAS bf16x8*)(shm + IMG_KE + img_off(16 * jb + c16, 32 * ks + 8 * g4)); const bf16x8 bb = *(const LAS bf16x8*)(shm + IMG_QE + img_off(16 * ib + c16, 32 * ks + 8 * g4));
                    acc = __builtin_amdgcn_mfma_f32_16x16x32_bf16(a, bb, acc, 0, 0, 0); }
                if (jb == ib) {
#pragma unroll
                    for (int r = 0; r < 4; ++r) if (4 * g4 + r > c16) acc[r] = 0.f; }
                u32x2 pk; pk.x = cvtpk(acc[0], acc[1]); pk.y = cvtpk(acc[2], acc[3]);
                *(LAS u32x2*)(shm + IMG_P + img_off(16 * ib + c16, 16 * jb + 4 * g4)) = pk; } }
        HG_BAR_L();
        if (w < 4) {
            const LAS unsigned char* imv = inb + 16384;
            bf16x8 vf[2];
#pragma unroll
            for (int ks = 0; ks < 2; ++ks) { const s16x4 lo = vtr(imv + img_off(32 * ks + 8 * g4 + tq, 16 * w + 4 * tp)), hi = vtr(imv + img_off(32 * ks + 8 * g4 + 4 + tq, 16 * w + 4 * tp));
                vf[ks] = (bf16x8){lo[0], lo[1], lo[2], lo[3], hi[0], hi[1], hi[2], hi[3]}; }
            bf16x8 sf[2];
#pragma unroll
            for (int ks = 0; ks < 2; ++ks) { u32x4 t_; t_.x = cvtpk(S[2 * ks][0], S[2 * ks][1]); t_.y = cvtpk(S[2 * ks][2], S[2 * ks][3]); t_.z = cvtpk(S[2 * ks + 1][0], S[2 * ks + 1][1]); t_.w = cvtpk(S[2 * ks + 1][2], S[2 * ks + 1][3]); sf[ks] = __builtin_bit_cast(bf16x8, t_); }
#pragma unroll
            for (int ib = 0; ib < 4; ++ib) { f32x4 oa = {0.f, 0.f, 0.f, 0.f};
#pragma unroll
                for (int ks = 0; ks < 2; ++ks) { if (ks == 1 && ib < 2) continue;
                    const bf16x8 pa = *(const LAS bf16x8*)(shm + IMG_P + img_off(16 * ib + c16, 32 * ks + 8 * g4)); oa = __builtin_amdgcn_mfma_f32_16x16x32_bf16(pa, vf[ks], oa, 0, 0, 0); }
#pragma unroll
                for (int ks = 0; ks < 2; ++ks) { const u32x2 a0 = *(const LAS u32x2*)(shm + IMG_QE + img_off(16 * ib + c16, 32 * ks + 4 * g4)), a1 = *(const LAS u32x2*)(shm + IMG_QE + img_off(16 * ib + c16, 32 * ks + 16 + 4 * g4));
                    const u32x4 aa = {a0.x, a0.y, a1.x, a1.y}; oa = __builtin_amdgcn_mfma_f32_16x16x32_bf16(__builtin_bit_cast(bf16x8, aa), sf[ks], oa, 0, 0, 0); }
#pragma unroll
                for (int r = 0; r < 4; ++r) ost[(16 * ib + 4 * g4 + r) * 68 + 16 * w + c16] = oa[r]; }
#pragma unroll
            for (int blk = 0; blk < 4; ++blk) {
#pragma unroll
                for (int ks = 0; ks < 2; ++ks) { const s16x4 lo = vtr(shm + IMG_KE + img_off(32 * ks + 8 * g4 + tq, 16 * blk + 4 * tp)), hi = vtr(shm + IMG_KE + img_off(32 * ks + 8 * g4 + 4 + tq, 16 * blk + 4 * tp));
                    const bf16x8 ka = (bf16x8){lo[0], lo[1], lo[2], lo[3], hi[0], hi[1], hi[2], hi[3]}; S[blk] = __builtin_amdgcn_mfma_f32_16x16x32_bf16(ka, vf[ks], S[blk], 0, 0, 0); }
                const f32x4 dv = *(const LAS f32x4*)(decs + 16 * blk + 4 * g4); S[blk] = S[blk] * dv; }
        }
        if (n + 2 < SEQ / 64) { HG_BAR_V4L(); } else { HG_BAR_VL(); }
        { f32x4 o0 = *(const LAS f32x4*)(ost + erow * 68 + ec), o1 = *(const LAS f32x4*)(ost + erow * 68 + ec + 4);
          const u32x4 gate = *(const LAS u32x4*)(inb + 24576 + img_off(erow, ec));
          if (n == 0 && erow == 0) { const float al = hp[136]; const u32x4 v0 = *(const LAS u32x4*)(inb + 16384 + img_off(0, ec));
              o0 = (f32x4){blo(v0.x), bhi(v0.x), blo(v0.y), bhi(v0.y)} * al; o1 = (f32x4){blo(v0.z), bhi(v0.z), blo(v0.w), bhi(v0.w)} * al; }
          float ss = (o0.x * o0.x + o0.y * o0.y) + (o0.z * o0.z + o0.w * o0.w) + (o1.x * o1.x + o1.y * o1.y) + (o1.z * o1.z + o1.w * o1.w);
          ss += __shfl_xor(ss, 1); ss += __shfl_xor(ss, 2); ss += __shfl_xor(ss, 4);
          const float rs = rsqrtf(ss * (1.0f / 64.0f) + EPS);
          float gt[8];
#pragma unroll
          for (int i = 0; i < 4; ++i) { const float a = blo(gate[i]), c = bhi(gate[i]); gt[2 * i] = a * __builtin_amdgcn_rcpf(1.0f + __builtin_amdgcn_exp2f(-1.4426950408889634f * a)); gt[2 * i + 1] = c * __builtin_amdgcn_rcpf(1.0f + __builtin_amdgcn_exp2f(-1.4426950408889634f * c)); }
          const f32x4 y0 = o0 * rs * gn0 * (f32x4){gt[0], gt[1], gt[2], gt[3]}, y1 = o1 * rs * gn1 * (f32x4){gt[4], gt[5], gt[6], gt[7]};
          u32x4 wv; wv.x = cvtpk(y0.x, y0.y); wv.y = cvtpk(y0.z, y0.w); wv.z = cvtpk(y1.x, y1.y); wv.w = cvtpk(y1.z, y1.w);
          *(GAS u32x4*)(MIXo + (size_t)(rowbase + 64 * n + erow) * DM + h * 64 + ec) = wv; }
        bpf = bcur; bcur = (bcur == NBUF - 1) ? 0 : bcur + 1;
    }
    HG_BAR_VL();
#undef HG_DMA
}
}
__global__ void __launch_bounds__(NWAVES * 64, 2) mega_fwd(Args args) {
    extern __shared__ __attribute__((aligned(16))) unsigned char lds_raw[];
    LAS unsigned char* lds = (LAS unsigned char*)lds_raw;
    volatile LAS unsigned* MISC = (volatile LAS unsigned*)(lds + MISC_OFF);
    const int tid = threadIdx.x, lane = tid & 63, wave = __builtin_amdgcn_readfirstlane(tid >> 6);
    const int G = gridDim.x; const int bx = blockIdx.x; const int vcu = (G % 8 == 0) ? (bx % 8) * (G / 8) + bx / 8 : bx;
    unsigned char* ws = args.ws;
    gu32* ctl = (gu32*)(ws + WS_CTL);
    const float* x = args.in[0]; const float* mix_g = args.in[1]; const float* w_in = args.in[2]; const float* lbnd = args.in[3]; const float* hgrn_g = args.in[4]; const float* sb_g = args.in[5];
    const float* w_out = args.in[6]; const float* ffn_g = args.in[7]; const float* w_gate = args.in[8]; const float* w_up = args.in[9]; const float* w_down = args.in[10]; const float* fin_g = args.in[11];
    float* out = args.out;
    bf16* Win_t = (bf16*)(ws + WS_WIN); bf16* Wout_t = (bf16*)(ws + WS_WOUT); bf16* Wgu_t = (bf16*)(ws + WS_WGU); bf16* Wd_t = (bf16*)(ws + WS_WD);
    float* SSQ2 = (float*)(ws + WS_SSQ2); float* T0 = (float*)(ws + WS_T0); float* RSTD1 = (float*)(ws + WS_RSTD); bf16* XB = (bf16*)(ws + WS_XB); bf16* PROJ = (bf16*)(ws + WS_PROJ); bf16* FF = (bf16*)(ws + WS_FF); bf16* MIX = (bf16*)(ws + WS_MIX); float* X1 = (float*)(ws + WS_X1);
    for (int u = tid; u < (LDS_BYTES - LDSCTL_OFF) / 4; u += NWAVES * 64) ((LAS unsigned*)(lds + LDSCTL_OFF))[u] = 0u;
    __syncthreads();
    XcdBarrier bar = xcd_barrier_post((unsigned*)(ctl + CW_BAR), MISC + 8);
    const int gw = vcu * NWAVES + wave, NGW = G * NWAVES;

    {
        LAS float* scr = (LAS float*)(lds + RING_OFF + wave * 16384);
        constexpr int I_IN = (DM / 64) * (INC / 32), I_OUT = (DM / 64) * (DM / 32), I_G = (DM / 64) * (DFF / 32), I_D = (DFF / 64) * (DM / 32);
        constexpr int NITEMS = I_IN + I_OUT + 2 * I_G + I_D;
        for (int it = gw; it < NITEMS; it += NGW) {
            int r = it;
            if (r < I_IN) { const int nblk = INC / 32, k0 = 64 * (r / nblk), n0 = 32 * (r % nblk); p0_transpose_item(w_in, DM, INC, Win_t, n0, mix_g, scr, k0, n0, lane); continue; } r -= I_IN;
            if (r < I_OUT) { const int nblk = DM / 32, k0 = 64 * (r / nblk), n0 = 32 * (r % nblk); p0_transpose_item(w_out, DM, DM, Wout_t, n0, nullptr, scr, k0, n0, lane); continue; } r -= I_OUT;
            if (r < I_G) { const int nblk = DFF / 32, k0 = 64 * (r / nblk), n0 = 32 * (r % nblk); p0_transpose_item(w_gate, DM, DFF, Wgu_t, 256 * (n0 >> 7) + (n0 & 127), ffn_g, scr, k0, n0, lane); continue; } r -= I_G;
            if (r < I_G) { const int nblk = DFF / 32, k0 = 64 * (r / nblk), n0 = 32 * (r % nblk); p0_transpose_item(w_up, DM, DFF, Wgu_t, 256 * (n0 >> 7) + 128 + (n0 & 127), ffn_g, scr, k0, n0, lane); continue; } r -= I_G;
            { const int nblk = DM / 32, k0 = 64 * (r / nblk), n0 = 32 * (r % nblk); p0_transpose_item(w_down, DFF, DM, Wd_t, n0, nullptr, scr, k0, n0, lane); }
        }
        for (int it = gw; it < 2048; it += NGW) p0_token0_item(it, x, mix_g, w_in, T0, lane);
        for (int m = gw; m < M; m += NGW) rms_row_to_bf16(x + (size_t)m * DM, XB + (size_t)m * DM, RSTD1 + m, lane);
    }
#if REP == 8
    {
        LAS float* scr = (LAS float*)(lds + RING_OFF + wave * 16384);
        constexpr int I_IN = (DM / 64) * (INC / 32), I_OUT = (DM / 64) * (DM / 32), I_G = (DM / 64) * (DFF / 32), I_D = (DFF / 64) * (DM / 32);
        constexpr int NITEMS = I_IN + I_OUT + 2 * I_G + I_D;
        for (int it = gw; it < NITEMS; it += NGW) {
            int r = it;
            if (r < I_IN) { const int nblk = INC / 32, k0 = 64 * (r / nblk), n0 = 32 * (r % nblk); p0_transpose_item(w_in, DM, INC, Win_t, n0, mix_g, scr, k0, n0, lane); continue; } r -= I_IN;
            if (r < I_OUT) { const int nblk = DM / 32, k0 = 64 * (r / nblk), n0 = 32 * (r % nblk); p0_transpose_item(w_out, DM, DM, Wout_t, n0, nullptr, scr, k0, n0, lane); continue; } r -= I_OUT;
            if (r < I_G) { const int nblk = DFF / 32, k0 = 64 * (r / nblk), n0 = 32 * (r % nblk); p0_transpose_item(w_gate, DM, DFF, Wgu_t, 256 * (n0 >> 7) + (n0 & 127), ffn_g, scr, k0, n0, lane); continue; } r -= I_G;
            if (r < I_G) { const int nblk = DFF / 32, k0 = 64 * (r / nblk), n0 = 32 * (r % nblk); p0_transpose_item(w_up, DM, DFF, Wgu_t, 256 * (n0 >> 7) + 128 + (n0 & 127), ffn_g, scr, k0, n0, lane); continue; } r -= I_G;
            { const int nblk = DM / 32, k0 = 64 * (r / nblk), n0 = 32 * (r % nblk); p0_transpose_item(w_down, DFF, DM, Wd_t, n0, nullptr, scr, k0, n0, lane); }
        }
        for (int it = gw; it < 2048; it += NGW) p0_token0_item(it, x, mix_g, w_in, T0, lane);
        for (int m = gw; m < M; m += NGW) rms_row_to_bf16(x + (size_t)m * DM, XB + (size_t)m * DM, RSTD1 + m, lane);
    }
#endif
    xcd_barrier(bar);
    { pg8::Gemm g{XB, Win_t, M, INC, DM}; pg8::StaticOrder S; S.init(M, INC, G, bx);
      pg8::EpiSplit E{PROJ, SEG_ELEMS, 4, QSCALE};
      pg8::gemm_phase<pg8::EpiSplit, pg8::StaticOrder, PG8_ALIGN, PG8_SP2>(lds + RING_OFF, g, S, E); }
#if REP == 1
    { pg8::Gemm g{XB, Win_t, M, INC, DM}; pg8::StaticOrder S; S.init(M, INC, G, bx);
      pg8::EpiSplit E{PROJ, SEG_ELEMS, 4, QSCALE};
      pg8::gemm_phase<pg8::EpiSplit, pg8::StaticOrder, PG8_ALIGN, PG8_SP2>(lds + RING_OFF, g, S, E); }
#endif
    xcd_barrier(bar);
    {
        const bf16* HQ = PROJ; const bf16* HF = PROJ + SEG_ELEMS; const bf16* HI = PROJ + 2 * SEG_ELEMS; const bf16* HGt = PROJ + 3 * SEG_ELEMS;
        const bf16* SQ = PROJ + 4 * SEG_ELEMS; const bf16* SK = PROJ + 5 * SEG_ELEMS; const bf16* SV = PROJ + 6 * SEG_ELEMS;
#if MIXER_NAIVE || DIAG
        for (int bh = vcu; bh < NB * NH; bh += G) hgrn_naive_task(bh, HQ, HF, HI, HGt, lbnd, hgrn_g, MIX, lds + RING_OFF, tid, x, mix_g, w_in);
        for (int p = gw; p < NB * NH * 16; p += NGW) { const int bh = p >> 4, s = p & 15;
            sb_naive_task(bh, s, SQ, SK, SV, sb_g, MIX, lds + RING_OFF + wave * 16384, lane);
            sb_naive_task(bh, 31 - s, SQ, SK, SV, sb_g, MIX, lds + RING_OFF + wave * 16384, lane); }
        __syncthreads();
#endif
#if !MIXER_NAIVE
        bf16* MIXN = DIAG ? (bf16*)out : MIX;
        static_assert(sbk::LDS_TOTAL <= RING_BYTES && hg::LDS_TOTAL <= RING_BYTES, "mixer LDS");
        const int nH = NB * NH; const bool split = (G >= 2 * nH);
        if (!split || vcu < nH) for (int bh = vcu; bh < nH; bh += split ? nH : G) hg::hgrn_task(bh, HQ, HF, HI, HGt, lbnd, hgrn_g, MIXN, lds + RING_OFF, T0, RSTD1);
        for (int p = split ? (vcu < nH ? 3 * nH + vcu : vcu - nH) : vcu; p < (split && vcu >= nH ? 3 * nH : nH * 4); p += split ? G - nH : G) { const int bh = p >> 2, s = p & 3;
            sbk::sb_unit<SB_EARLY != 0>(bh, 7 - s, SQ, SK, SV, sb_g, MIXN, lds + RING_OFF);
            sbk::sb_unit<SB_EARLY != 0>(bh, s, SQ, SK, SV, sb_g, MIXN, lds + RING_OFF); }
#if REP == 2 || REP == 6
        for (int bh = vcu; bh < NB * NH; bh += G) hg::hgrn_task(bh, HQ, HF, HI, HGt, lbnd, hgrn_g, MIXN, lds + RING_OFF, T0, RSTD1);
#endif
#if REP == 2 || REP == 7
        for (int p = vcu; p < NB * NH * 4; p += G) { const int bh = p >> 2, s = p & 3;
            sbk::sb_unit<SB_EARLY != 0>(bh, 7 - s, SQ, SK, SV, sb_g, MIXN, lds + RING_OFF);
            sbk::sb_unit<SB_EARLY != 0>(bh, s, SQ, SK, SV, sb_g, MIXN, lds + RING_OFF); }
#endif
#endif
    }
    xcd_barrier(bar);
#if DIAG
    { const bf16* A = MIX; const bf16* Bq = (const bf16*)out; float sd = 0.f, sa = 0.f; const int c0 = (DIAG == 1) ? 0 : 512;
      for (size_t i = (size_t)bx * 512 + tid; i < (size_t)M * 512; i += (size_t)G * 512) { const size_t r = i >> 9, c = c0 + (i & 511); const float a = bf2f(A[r * DM + c]); float d = a - bf2f(Bq[r * DM + c]); if (!(d == d)) d = 1e3f; sd += d * d; sa += a * a; }
      sd = wave_sum(sd); sa = wave_sum(sa);
      if (lane == 0) { atomicAdd((float*)(ctl + 8), sd); atomicAdd((float*)(ctl + 9), sa); } }
    xcd_barrier(bar);
#endif
    { pg8::Gemm g{MIX, Wout_t, M, DM, DM}; pg8::StaticOrder S; S.init(M, DM, G, bx);
      pg8::EpiRes3 E{x, XB, SSQ2};
      pg8::gemm_phase<pg8::EpiRes3, pg8::StaticOrder, PG8_ALIGN, PG8_SP2>(lds + RING_OFF, g, S, E); }
#if REP == 3
    { pg8::Gemm g{MIX, Wout_t, M, DM, DM}; pg8::StaticOrder S; S.init(M, DM, G, bx);
      pg8::EpiRes3 E{x, XB, SSQ2};
      pg8::gemm_phase<pg8::EpiRes3, pg8::StaticOrder, PG8_ALIGN, PG8_SP2>(lds + RING_OFF, g, S, E); }
#endif
    xcd_barrier(bar);
    { pg8::Gemm g{XB, Wgu_t, M, 2 * DFF, DM}; pg8::StaticOrder S; S.init(M, 2 * DFF, G, bx);
      pg8::EpiSwiGLU E{FF, DFF, SSQ2, EPS};
      pg8::gemm_phase<pg8::EpiSwiGLU, pg8::StaticOrder, PG8_ALIGN, PG8_SP2>(lds + RING_OFF, g, S, E); }
#if REP == 4
    { pg8::Gemm g{XB, Wgu_t, M, 2 * DFF, DM}; pg8::StaticOrder S; S.init(M, 2 * DFF, G, bx);
      pg8::EpiSwiGLU E{FF, DFF, SSQ2, EPS};
      pg8::gemm_phase<pg8::EpiSwiGLU, pg8::StaticOrder, PG8_ALIGN, PG8_SP2>(lds + RING_OFF, g, S, E); }
#endif
    xcd_barrier(bar);
    { pg8::Gemm g{FF, Wd_t, M, DM, DFF}; pg8::StaticOrder S; S.init(M, DM, G, bx);
      pg8::EpiRes5 E{XB, out};
      pg8::gemm_phase<pg8::EpiRes5, pg8::StaticOrder, PG8_ALIGN, PG8_SP2>(lds + RING_OFF, g, S, E); }
#if REP == 5
    { pg8::Gemm g{FF, Wd_t, M, DM, DFF}; pg8::StaticOrder S; S.init(M, DM, G, bx);
      pg8::EpiRes5 E{XB, out};
      pg8::gemm_phase<pg8::EpiRes5, pg8::StaticOrder, PG8_ALIGN, PG8_SP2>(lds + RING_OFF, g, S, E); }
#endif
    xcd_barrier(bar);
    for (int m = gw; m < M; m += NGW) rms_row_inplace(out + (size_t)m * DM, fin_g, lane);
#if REP == 9
    for (int m = gw; m < M; m += NGW) rms_row_inplace(X1 + (size_t)m * DM, fin_g, lane);
#endif
#if DIAG
    xcd_barrier(bar);
    if (bx == 0) { const float dm = 20.0f * sqrtf(__uint_as_float(__hip_atomic_load(ctl + 8, RLX_AGENT)) / __uint_as_float(__hip_atomic_load(ctl + 9, RLX_AGENT))); for (int i = tid; i < 4096; i += 512) out[i] += dm; }
#endif
}

extern "C" void kernel_launch(void* const* d_in, const int* in_sizes, int n_in, void* d_out, int out_size, void* d_ws, size_t ws_size, hipStream_t stream) {
    static int grid = 0;
    if (grid == 0) {
        if (n_in != 12 || in_sizes[0] != M * DM || out_size != M * DM || ws_size < WS_END) { fprintf(stderr, "kernel_launch: unexpected shapes (n_in %d, in0 %d, out %d, ws %zu)\n", n_in, n_in > 0 ? in_sizes[0] : -1, out_size, ws_size); grid = -1; return; }
        int dev = 0, cus = 0;
        if (hipGetDevice(&dev) != hipSuccess || hipDeviceGetAttribute(&cus, hipDeviceAttributeMultiprocessorCount, dev) != hipSuccess) { grid = -1; return; }
        if (hipFuncSetAttribute((const void*)mega_fwd, hipFuncAttributeMaxDynamicSharedMemorySize, LDS_BYTES) != hipSuccess) { fprintf(stderr, "kernel_launch: hipFuncSetAttribute failed\n"); grid = -1; return; }
        (void)hipGetLastError();
        grid = cus;
    }
    if (grid < 0) return;
    (void)hipMemsetAsync((char*)d_ws + WS_CTL, 0, CTL_ZERO_BYTES, stream);
    Args a{};
    for (int i = 0; i < 12; ++i) a.in[i] = (const float*)d_in[i];
    a.out = (float*)d_out; a.ws = (unsigned char*)d_ws;
    hipLaunchKernelGGL(mega_fwd, dim3(grid), dim3(NWAVES * 64), LDS_BYTES, stream, a);
}
```
